# Optimizing an MI355X kernel written in HIP

```python
import math
import jax, jax.numpy as jnp
from jax import lax
import numpy as np

D_MODEL = 4096
BATCH = 1
SEQ = 8192
DEPTH = 1

HEAD_DIM = 128
N_HEADS = D_MODEL // (2 * HEAD_DIM)
N_KV_HEADS = 4
GROUP = N_HEADS // N_KV_HEADS
ATTN_WIDTH = N_HEADS * HEAD_DIM
KV_WIDTH = N_KV_HEADS * HEAD_DIM
WINDOW = 128
BLOCK = 128
POOL_WIDTH = D_MODEL - ATTN_WIDTH
POOL_WINDOWS = (2, 4, 8, 16)
N_POOL_GROUPS = len(POOL_WINDOWS)
POOL_GROUP_W = POOL_WIDTH // N_POOL_GROUPS
MIX_WIDTH = ATTN_WIDTH + POOL_WIDTH
IN_COLS = ATTN_WIDTH + 2 * KV_WIDTH + POOL_WIDTH
D_FF = int(math.ceil(8 * D_MODEL / 3 / 256)) * 256
RMS_EPS = 1e-6
NEG_INF = -1e30

kernel_name = "hybrid_swa_alibi_multiscale_pool_block"


def _rmsnorm(x, g):
    xf = x.astype(jnp.float32)
    y = xf * lax.rsqrt(jnp.mean(xf * xf, axis=-1, keepdims=True) + RMS_EPS)
    return (y * g.astype(jnp.float32)).astype(x.dtype)


def _alibi_slopes(n):
    return 2.0 ** (-8.0 * jnp.arange(1, n + 1, dtype=jnp.float32) / n)


def _banded_window_attention(q, k, v, sink_logits):
    B, S, H, D = q.shape
    n = S // BLOCK
    pad = ((0, 0), (BLOCK, BLOCK), (0, 0), (0, 0))
    kp = jnp.pad(k, pad).reshape(B, n + 2, BLOCK, N_KV_HEADS, D)
    vp = jnp.pad(v, pad).reshape(B, n + 2, BLOCK, N_KV_HEADS, D)
    kb = jnp.concatenate([kp[:, :-2], kp[:, 1:-1], kp[:, 2:]], axis=2)
    vb = jnp.concatenate([vp[:, :-2], vp[:, 1:-1], vp[:, 2:]], axis=2)
    qb = q.reshape(B, n, BLOCK, N_KV_HEADS, GROUP, D)
    s = jnp.einsum('bnqkgd,bnskd->bnkgqs', qb, kb,
                   preferred_element_type=jnp.float32)
    qi = jnp.arange(BLOCK)[:, None]
    kj = jnp.arange(3 * BLOCK)[None, :]
    dist = kj - BLOCK - qi
    kpos = jnp.arange(n)[:, None] * BLOCK - BLOCK + jnp.arange(3 * BLOCK)[None, :]
    valid = (jnp.abs(dist) <= WINDOW)[None] & ((kpos >= 0) & (kpos < S))[:, None, :]
    slopes = _alibi_slopes(N_HEADS).reshape(N_KV_HEADS, GROUP, 1, 1)
    bias = -slopes * jnp.abs(dist).astype(jnp.float32)
    logits = jnp.where(valid[None, :, None, None], s + bias[None, None], NEG_INF)
    sink = sink_logits.astype(jnp.float32).reshape(1, 1, N_KV_HEADS, GROUP, 1, 1)
    lse = jnp.logaddexp(jax.nn.logsumexp(logits, axis=-1, keepdims=True), sink)
    p = jnp.exp(logits - lse)
    o = jnp.einsum('bnkgqs,bnskd->bnqkgd', p.astype(v.dtype), vb)
    return o.reshape(B, S, H * D)


def _multiscale_pool(p, pool_w, pool_scale):
    B, S, _ = p.shape
    pf = p.astype(jnp.float32).reshape(B, S, N_POOL_GROUPS, POOL_GROUP_W)
    cs = jnp.concatenate([jnp.zeros((B, 1, N_POOL_GROUPS, POOL_GROUP_W), jnp.float32),
                          jnp.cumsum(pf, axis=1)], axis=1)
    t = jnp.arange(S)
    outs = []
    for gi, w in enumerate(POOL_WINDOWS):
        left = w // 2
        right = w - 1 - left
        lo = jnp.clip(t - left, 0, S)
        hi = jnp.clip(t + right + 1, 0, S)
        seg = cs[:, :, gi]
        win_sum = jnp.take(seg, hi, axis=1) - jnp.take(seg, lo, axis=1)
        cnt = (hi - lo).astype(jnp.float32)[None, :, None]
        outs.append(win_sum / cnt - pf[:, :, gi])
    u = jnp.stack(outs, axis=2).astype(p.dtype)
    y = jnp.einsum('bsgc,gcd->bsgd', u, pool_w).reshape(B, S, POOL_WIDTH)
    return y * pool_scale


def setup_inputs(seed: int = 0) -> dict:
    key = jax.random.key(seed)
    ks = jax.random.split(key, 13)
    f32 = jnp.float32
    nrm = lambda k, shape, fan_in: jax.random.normal(k, shape, f32) * (fan_in ** -0.5)
    return {
        "x": jax.random.normal(ks[0], (BATCH, SEQ, D_MODEL), f32),
        "norm1_g": 1.0 + 0.02 * jax.random.normal(ks[1], (D_MODEL,), f32),
        "w_in": nrm(ks[2], (D_MODEL, IN_COLS), D_MODEL),
        "q_norm_g": 1.0 + 0.02 * jax.random.normal(ks[3], (HEAD_DIM,), f32),
        "k_norm_g": 1.0 + 0.02 * jax.random.normal(ks[4], (HEAD_DIM,), f32),
        "sink_logits": 0.5 * jax.random.normal(ks[5], (N_HEADS,), f32),
        "pool_w": nrm(ks[6], (N_POOL_GROUPS, POOL_GROUP_W, POOL_GROUP_W), POOL_GROUP_W),
        "pool_scale": 1.0 + 0.02 * jax.random.normal(ks[7], (POOL_WIDTH,), f32),
        "w_out": nrm(ks[8], (MIX_WIDTH, D_MODEL), MIX_WIDTH),
        "norm2_g": 1.0 + 0.02 * jax.random.normal(ks[9], (D_MODEL,), f32),
        "w_gate": nrm(ks[10], (D_MODEL, D_FF), D_MODEL),
        "w_up": nrm(ks[11], (D_MODEL, D_FF), D_MODEL),
        "w_down": nrm(ks[12], (D_FF, D_MODEL), D_FF),
    }


def reference(x, norm1_g, w_in, q_norm_g, k_norm_g, sink_logits, pool_w, pool_scale,
              w_out, norm2_g, w_gate, w_up, w_down):
    B, S, _ = x.shape
    for _layer in range(DEPTH):
        h = _rmsnorm(x, norm1_g)
        proj = h @ w_in
        q = proj[..., :ATTN_WIDTH].reshape(B, S, N_HEADS, HEAD_DIM)
        k = proj[..., ATTN_WIDTH:ATTN_WIDTH + KV_WIDTH].reshape(B, S, N_KV_HEADS, HEAD_DIM)
        v = proj[..., ATTN_WIDTH + KV_WIDTH:ATTN_WIDTH + 2 * KV_WIDTH].reshape(B, S, N_KV_HEADS, HEAD_DIM)
        p = proj[..., ATTN_WIDTH + 2 * KV_WIDTH:]
        q = _rmsnorm(q, q_norm_g) * jnp.asarray(HEAD_DIM ** -0.5, q.dtype)
        k = _rmsnorm(k, k_norm_g)
        attn_out = _banded_window_attention(q, k, v, sink_logits)
        pool_out = _multiscale_pool(p, pool_w, pool_scale)
        mixed = jnp.concatenate([attn_out, pool_out], axis=-1)
        x = x + mixed @ w_out
        h2 = _rmsnorm(x, norm2_g)
        x = x + (jax.nn.silu(h2 @ w_gate) * (h2 @ w_up)) @ w_down
    return x
```

```cpp
#include <hip/hip_runtime.h>
#include <hip/hip_cooperative_groups.h>
#include <cstdio>
#include <cstdint>
namespace cg = cooperative_groups;

#define LAS __attribute__((address_space(3)))
typedef unsigned short bf16_t;
typedef short bf16x8 __attribute__((ext_vector_type(8)));
typedef float f32x4 __attribute__((ext_vector_type(4)));
typedef float f32x16 __attribute__((ext_vector_type(16)));
typedef unsigned u32x4 __attribute__((ext_vector_type(4)));
typedef unsigned u32x2 __attribute__((ext_vector_type(2)));
typedef float f32x2_t __attribute__((ext_vector_type(2)));
typedef __bf16 bf16x2_t __attribute__((ext_vector_type(2)));

constexpr int SEQ = 8192, DM = 4096, HD = 128, NH = 16, NKV = 4, INC = 5120, DFF = 11008, PW = 2048, PGW = 512;
constexpr int QOFF = 0, KOFF = 2048, VOFF = 2560, POFF = 3072;
constexpr float EPS = 1e-6f;
constexpr float LOG2E = 1.4426950408889634f;

constexpr size_t MiB = 1u << 20;
constexpr size_t WS_WIN = 0 * MiB;
constexpr size_t WS_PWT = 40 * MiB;
constexpr size_t WS_WO = 42 * MiB;
constexpr size_t WS_WGU = 74 * MiB;
constexpr size_t WS_WD = 246 * MiB;
constexpr size_t WS_XN = 332 * MiB;
constexpr size_t WS_SSQ = 396 * MiB;
constexpr size_t WS_QKVP = 398 * MiB;
constexpr size_t WS_MIX = 478 * MiB;
constexpr size_t WS_U = 542 * MiB;
constexpr size_t WS_H = 398 * MiB;
constexpr size_t WS_CTL = 574 * MiB;
constexpr size_t CTL_BYTES = 16384;
constexpr size_t WS_END = 575 * MiB;

constexpr int LDS_BYTES = 147456;
constexpr int LDS_MISC = LDS_BYTES - 64;
constexpr int NWAVES = 8;
constexpr int P1_GEMM_CUS = 216;

__device__ __forceinline__ unsigned cvtpk(float lo, float hi) { f32x2_t v = {lo, hi}; bf16x2_t b = __builtin_convertvector(v, bf16x2_t); return __builtin_bit_cast(unsigned, b); }
__device__ __forceinline__ float bflo(unsigned w) { return __uint_as_float(w << 16); }
__device__ __forceinline__ float bfhi(unsigned w) { return __uint_as_float(w & 0xffff0000u); }
__device__ __forceinline__ void st16_wt(void* p, u32x4 v) { asm volatile("global_store_dwordx4 %0, %1, off sc1\n\ts_nop 1" :: "v"(p), "v"(v) : "memory"); }

#ifndef PG8_SP2_DEFAULT
#define PG8_SP2_DEFAULT true
#endif
namespace pg8 {
constexpr int BM = 256, BK = 64, HALF = 128, HTB = HALF * BK * 2, STAGE_BYTES = 8 * HTB, NXCD = 8, WGM = 8;
__host__ __device__ __forceinline__ int lds_byte(int r, int c) { const int st = (r >> 4) * 2 + (c >> 5), rr = r & 15, cc = c & 31, ob = rr * 64 + cc * 2; return st * 1024 + (ob ^ (((ob >> 9) & 1) << 5)); }
__host__ __device__ __forceinline__ void stage_rc(int b, int& R, int& C) { const int st = b / 1024, sb = b % 1024, swz = sb ^ (((sb >> 9) & 1) << 5); R = (st >> 1) * 16 + swz / 64; C = (st & 1) * 32 + (swz % 64) / 2; }
__host__ __device__ __forceinline__ int perm32(int rho) { const int n = rho >> 4, i = rho & 15; return 8 * (i >> 2) + 4 * n + (i & 3); }

struct Unit { int pm, pn; };
struct Gemm { const bf16_t* A; const bf16_t* Bt; int lda, ldb, K; long a_grp_stride; int a_grp_shift; };

struct StaticOrder {
    int nM, nN, nwg, G, c;
    __device__ void init(int M, int N, int G_, int c_) { nM = M / BM; nN = N / BM; nwg = nM * nN; G = G_; c = c_; }
    __device__ bool next(int i, Unit& u) const {
        const long L = (long)i * G + c; if (L >= nwg) return false;
        int wgid = (int)L; { const int q = nwg / NXCD, r = nwg % NXCD, xcd = wgid % NXCD, off = wgid / NXCD; wgid = (xcd < r ? xcd * (q + 1) : r * (q + 1) + (xcd - r) * q) + off; }
        const int nig = WGM * nN, gid = wgid / nig, fm = gid * WGM, gsz = (nM - fm) < WGM ? (nM - fm) : WGM;
        u.pm = fm + ((wgid % nig) % gsz); u.pn = (wgid % nig) / gsz; return true;
    }
};


struct EpiStore {
    bf16_t* O; int ldc;
    __device__ __forceinline__ void operator()(const f32x4 (&acc)[2][2][4][2], const Unit& u, int wr, int wc, int fr, int fq) const {
        const int row0 = u.pm * BM + wr * 64 + fr, col0 = u.pn * BM + wc * 32 + 8 * fq;
#pragma unroll
        for (int ai = 0; ai < 2; ++ai)
#pragma unroll
            for (int m = 0; m < 4; ++m) { bf16_t* rowp = O + (size_t)(row0 + ai * HALF + m * 16) * ldc + col0;
#pragma unroll
                for (int bj = 0; bj < 2; ++bj) { const f32x4 v0 = acc[ai][bj][m][0], v1 = acc[ai][bj][m][1];
                    u32x4 w; w.x = cvtpk(v0[0], v0[1]); w.y = cvtpk(v0[2], v0[3]); w.z = cvtpk(v1[0], v1[1]); w.w = cvtpk(v1[2], v1[3]);
                    *(u32x4*)(rowp + bj * HALF) = w; } }
    }
};
struct EpiPool {
    bf16_t* O; int ldc; int coloff; const float* scale;
    __device__ __forceinline__ void operator()(const f32x4 (&acc)[2][2][4][2], const Unit& u, int wr, int wc, int fr, int fq) const {
        const int row0 = u.pm * BM + wr * 64 + fr, col0 = u.pn * BM + wc * 32 + 8 * fq;
        f32x4 sv[2][2];
#pragma unroll
        for (int bj = 0; bj < 2; ++bj)
#pragma unroll
            for (int n = 0; n < 2; ++n) sv[bj][n] = *(const f32x4*)(scale + col0 + bj * HALF + 4 * n);
#pragma unroll
        for (int ai = 0; ai < 2; ++ai)
#pragma unroll
            for (int m = 0; m < 4; ++m) { bf16_t* rowp = O + (size_t)(row0 + ai * HALF + m * 16) * ldc + coloff + col0;
#pragma unroll
                for (int bj = 0; bj < 2; ++bj) { const f32x4 v0 = acc[ai][bj][m][0] * sv[bj][0], v1 = acc[ai][bj][m][1] * sv[bj][1];
                    u32x4 w; w.x = cvtpk(v0[0], v0[1]); w.y = cvtpk(v0[2], v0[3]); w.z = cvtpk(v1[0], v1[1]); w.w = cvtpk(v1[2], v1[3]);
                    *(u32x4*)(rowp + bj * HALF) = w; } }
    }
};
struct EpiWout {
    const float* X; bf16_t* xb; float* ssq;
    __device__ __forceinline__ void operator()(const f32x4 (&acc)[2][2][4][2], const Unit& u, int wr, int wc, int fr, int fq) const {
        const int row0 = u.pm * BM + wr * 64 + fr, col0 = u.pn * BM + wc * 32 + 8 * fq;
#pragma unroll
        for (int ai = 0; ai < 2; ++ai)
#pragma unroll
            for (int m = 0; m < 4; ++m) { const int row = row0 + ai * HALF + m * 16; const size_t off = (size_t)row * DM + col0; float s = 0.f;
#pragma unroll
                for (int bj = 0; bj < 2; ++bj) {
                    const f32x4 x0 = __builtin_nontemporal_load((const f32x4*)(X + off + bj * HALF)), x1 = __builtin_nontemporal_load((const f32x4*)(X + off + bj * HALF + 4));
                    const f32x4 v0 = acc[ai][bj][m][0] + x0, v1 = acc[ai][bj][m][1] + x1;
                    u32x4 w; w.x = cvtpk(v0[0], v0[1]); w.y = cvtpk(v0[2], v0[3]); w.z = cvtpk(v1[0], v1[1]); w.w = cvtpk(v1[2], v1[3]);
                    *(u32x4*)(xb + off + bj * HALF) = w;
                    s += (v0[0] * v0[0] + v0[1] * v0[1]) + (v0[2] * v0[2] + v0[3] * v0[3]) + (v1[0] * v1[0] + v1[1] * v1[1]) + (v1[2] * v1[2] + v1[3] * v1[3]); }
                s += __shfl_xor(s, 16); s += __shfl_xor(s, 32);
                if (fq == 0) ssq[(size_t)row * 64 + u.pn * 4 + wc] = s; }
    }
};
struct EpiGateUp {
    bf16_t* H; const float* ssq; const LAS float* rstd_lds; int pm_cached;
    __device__ __forceinline__ void operator()(const f32x4 (&acc)[2][2][4][2], const Unit& u, int wr, int wc, int fr, int fq) const {
        const int row0 = u.pm * BM + wr * 64 + fr, col0 = u.pn * HALF + wc * 32 + 8 * fq;
        const bool cached = (u.pm == pm_cached);
#pragma unroll
        for (int ai = 0; ai < 2; ++ai)
#pragma unroll
            for (int m = 0; m < 4; ++m) { const int row = row0 + ai * HALF + m * 16;
                float rstd;
                if (cached) rstd = rstd_lds[row - u.pm * BM];
                else {
                    const f32x4* sp = (const f32x4*)(ssq + (size_t)row * 64 + fq * 16);
                    const f32x4 a = sp[0], b = sp[1], c = sp[2], d = sp[3];
                    float s = ((a[0] + a[1]) + (a[2] + a[3])) + ((b[0] + b[1]) + (b[2] + b[3])) + ((c[0] + c[1]) + (c[2] + c[3])) + ((d[0] + d[1]) + (d[2] + d[3]));
                    s += __shfl_xor(s, 16); s += __shfl_xor(s, 32);
                    rstd = __builtin_amdgcn_rsqf(s * (1.0f / DM) + EPS);
                }
                float hv[8];
#pragma unroll
                for (int n = 0; n < 2; ++n)
#pragma unroll
                    for (int i = 0; i < 4; ++i) { const float g = acc[ai][0][m][n][i] * rstd, up = acc[ai][1][m][n][i] * rstd;
                        hv[4 * n + i] = g * __builtin_amdgcn_rcpf(1.0f + __expf(-g)) * up; }
                u32x4 w; w.x = cvtpk(hv[0], hv[1]); w.y = cvtpk(hv[2], hv[3]); w.z = cvtpk(hv[4], hv[5]); w.w = cvtpk(hv[6], hv[7]);
                *(u32x4*)(H + (size_t)row * DFF + col0) = w; }
    }
};
struct EpiDown {
    float* out; const bf16_t* xb;
    __device__ __forceinline__ void operator()(const f32x4 (&acc)[2][2][4][2], const Unit& u, int wr, int wc, int fr, int fq) const {
        const int row0 = u.pm * BM + wr * 64 + fr, col0 = u.pn * BM + wc * 32 + 8 * fq;
#pragma unroll
        for (int ai = 0; ai < 2; ++ai)
#pragma unroll
            for (int m = 0; m < 4; ++m) { const size_t off = (size_t)(row0 + ai * HALF + m * 16) * DM + col0;
#pragma unroll
                for (int bj = 0; bj < 2; ++bj) {
                    const u32x4 xw = *(const u32x4*)(xb + off + bj * HALF);
                    const f32x4 x0 = (f32x4){bflo(xw.x), bfhi(xw.x), bflo(xw.y), bfhi(xw.y)}, x1 = (f32x4){bflo(xw.z), bfhi(xw.z), bflo(xw.w), bfhi(xw.w)};
                    __builtin_nontemporal_store(acc[ai][bj][m][0] + x0, (f32x4*)(out + off + bj * HALF)); __builtin_nontemporal_store(acc[ai][bj][m][1] + x1, (f32x4*)(out + off + bj * HALF + 4)); } }
    }
};

template <class Epi, bool ALIGN_EPI, bool SP2 = PG8_SP2_DEFAULT>
__device__ __forceinline__ void gemm_phase(LAS unsigned char* lds, const Gemm g, const StaticOrder& S, const Epi& E) {
    int tid = threadIdx.x; asm volatile("" : "+v"(tid));
    const int wid = __builtin_amdgcn_readfirstlane(tid >> 6), lane = tid & 63, wr = wid >> 2, wc = wid & 3, fr = lane & 15, fq = lane >> 4;
    const int K = g.K, nt = K / BK;
    unsigned voffA[2], voffB[2];
#pragma unroll
    for (int i = 0; i < 2; ++i) { int R, C; stage_rc(tid * 16 + i * 8192, R, C); const int Rb = (R & ~31) + perm32(R & 31);
        voffA[i] = (unsigned)(R * g.lda + C) * 2u; voffB[i] = (unsigned)(Rb * g.ldb + C) * 2u; }
    const size_t kstep = (size_t)(BK * 2);
    const size_t hstepA = (size_t)HALF * g.lda * 2, hstepB = (size_t)HALF * g.ldb * 2;
    const size_t tstepA = 2 * hstepA, tstepB = 2 * hstepB;
    const unsigned ldsw = (unsigned)wid * 1024u;
    const int aoff = lds_byte(wr * 64 + fr, fq * 8), boff = lds_byte(wc * 32 + fr, fq * 8);
#define PG8_SA(b, h) (((b) * 2 + (h)) * HTB)
#define PG8_SB(b, h) ((4 + (b) * 2 + (h)) * HTB)
#define PG8_STAGE(bufoff, gbase, voff) do { _Pragma("unroll") for (int _i = 0; _i < 2; ++_i) \
        __builtin_amdgcn_global_load_lds((const unsigned*)((const char*)(gbase) + (voff)[_i]), (LAS unsigned*)(lds + (bufoff) + ldsw + _i * 8192), 16, 0, 0); } while (0)
#define PG8_LDA(dst, b, h) do { _Pragma("unroll") for (int m = 0; m < 4; ++m) _Pragma("unroll") for (int k = 0; k < 2; ++k) dst[m][k] = *(const LAS bf16x8*)(lds + PG8_SA(b, h) + aoff + m * 2048 + k * 1024); } while (0)
#define PG8_LDB(dst, b, h) do { _Pragma("unroll") for (int n = 0; n < 2; ++n) _Pragma("unroll") for (int k = 0; k < 2; ++k) dst[n][k] = *(const LAS bf16x8*)(lds + PG8_SB(b, h) + boff + n * 2048 + k * 1024); } while (0)
#define PG8_MMA(ai, bj, At, Bt) do { __builtin_amdgcn_s_setprio(1); _Pragma("unroll") for (int m = 0; m < 4; ++m) _Pragma("unroll") for (int n = 0; n < 2; ++n) _Pragma("unroll") for (int k = 0; k < 2; ++k) \
        acc[ai][bj][m][n] = __builtin_amdgcn_mfma_f32_16x16x32_bf16(Bt[n][k], At[m][k], acc[ai][bj][m][n], 0, 0, 0); __builtin_amdgcn_s_setprio(0); } while (0)
#define PG8_WAIT_V(n) asm volatile("s_waitcnt vmcnt(" #n ")" ::: "memory")
#define PG8_WAIT_L(n) asm volatile("s_waitcnt lgkmcnt(" #n ")" ::: "memory")
#define PG8_BAR __builtin_amdgcn_s_barrier()
#define PG8_SCHED __builtin_amdgcn_sched_barrier(0)
#define PG8_ABASE(u) ((const char*)g.A + ((size_t)((u).pn >> g.a_grp_shift) * (size_t)g.a_grp_stride) * 2 + (size_t)(u).pm * tstepA)
    Unit cur, nxt; int ui = 0;
    if (!S.next(0, cur)) return;
    f32x4 acc[2][2][4][2];
#pragma unroll
    for (int a = 0; a < 2; ++a)
#pragma unroll
        for (int b = 0; b < 2; ++b)
#pragma unroll
            for (int m = 0; m < 4; ++m)
#pragma unroll
                for (int n = 0; n < 2; ++n) acc[a][b][m][n] = (f32x4){0.f, 0.f, 0.f, 0.f};
    bf16x8 At[4][2], B0[2][2], B1[2][2];
    const char* cA = PG8_ABASE(cur); const char* cB = (const char*)g.Bt + (size_t)cur.pn * tstepB;
    if constexpr (SP2) {
    PG8_STAGE(PG8_SB(0, 0), cB, voffB); PG8_STAGE(PG8_SB(0, 1), cB + hstepB, voffB); PG8_STAGE(PG8_SA(0, 0), cA, voffA); PG8_STAGE(PG8_SA(0, 1), cA + hstepA, voffA);
    if (wr == 1) PG8_BAR;
    PG8_WAIT_V(2); PG8_BAR;
    PG8_STAGE(PG8_SB(1, 0), cB + kstep, voffB); PG8_STAGE(PG8_SA(1, 0), cA + kstep, voffA); PG8_STAGE(PG8_SB(1, 1), cB + hstepB + kstep, voffB);
    PG8_WAIT_V(6); PG8_BAR;
    } else {
    PG8_STAGE(PG8_SB(0, 0), cB, voffB); PG8_STAGE(PG8_SA(0, 0), cA, voffA); PG8_STAGE(PG8_SB(0, 1), cB + hstepB, voffB); PG8_STAGE(PG8_SA(0, 1), cA + hstepA, voffA);
    if (wr == 1) PG8_BAR;
    PG8_WAIT_V(4); PG8_BAR;
    PG8_STAGE(PG8_SB(1, 0), cB + kstep, voffB); PG8_STAGE(PG8_SA(1, 0), cA + kstep, voffA); PG8_STAGE(PG8_SB(1, 1), cB + hstepB + kstep, voffB);
    PG8_WAIT_V(6); PG8_BAR;
    }
    for (;;) {
        const bool has_next = S.next(ui + 1, nxt);
        const char* nA = has_next ? PG8_ABASE(nxt) : cA; const char* nB = has_next ? (const char*)g.Bt + (size_t)nxt.pn * tstepB : cB;
        for (int t = 0; t < nt; t += 2) {
            const bool last = (t == nt - 2);
            const char* a1 = cA + (size_t)(t + 1) * kstep;
            const char* a2 = last ? nA : cA + (size_t)(t + 2) * kstep; const char* b2 = last ? nB : cB + (size_t)(t + 2) * kstep;
            const char* a3 = a2 + kstep; const char* b3 = b2 + kstep;
            if constexpr (SP2) {
            PG8_LDB(B0, 0, 0); PG8_LDB(B1, 0, 1); PG8_SCHED; PG8_LDA(At, 0, 0); PG8_STAGE(PG8_SA(1, 1), a1 + hstepA, voffA);
            PG8_WAIT_V(8); PG8_WAIT_L(0); PG8_BAR; PG8_MMA(0, 0, At, B0); PG8_MMA(0, 1, At, B1); PG8_BAR; PG8_SCHED;
            PG8_LDA(At, 0, 1); PG8_STAGE(PG8_SB(0, 0), b2, voffB); PG8_STAGE(PG8_SB(0, 1), b2 + hstepB, voffB); PG8_STAGE(PG8_SA(0, 0), a2, voffA);
            PG8_WAIT_V(8); PG8_WAIT_L(0); PG8_BAR; PG8_MMA(1, 0, At, B0); PG8_MMA(1, 1, At, B1); PG8_BAR; PG8_SCHED;
            PG8_LDB(B0, 1, 0); PG8_LDB(B1, 1, 1); PG8_SCHED; PG8_LDA(At, 1, 0); PG8_STAGE(PG8_SA(0, 1), a2 + hstepA, voffA);
            PG8_WAIT_V(8); PG8_WAIT_L(0); PG8_BAR; PG8_MMA(0, 0, At, B0); PG8_MMA(0, 1, At, B1); PG8_BAR; PG8_SCHED;
            PG8_LDA(At, 1, 1); PG8_STAGE(PG8_SB(1, 0), b3, voffB); PG8_STAGE(PG8_SB(1, 1), b3 + hstepB, voffB); PG8_STAGE(PG8_SA(1, 0), a3, voffA);
            PG8_WAIT_V(8); PG8_WAIT_L(0); PG8_BAR; PG8_MMA(1, 0, At, B0); PG8_MMA(1, 1, At, B1); PG8_BAR; PG8_SCHED;
            } else {
            PG8_LDB(B0, 0, 0); PG8_SCHED; PG8_LDA(At, 0, 0); PG8_STAGE(PG8_SA(1, 1), a1 + hstepA, voffA);
            PG8_WAIT_L(8); PG8_BAR; PG8_WAIT_L(0); PG8_MMA(0, 0, At, B0); PG8_BAR; PG8_SCHED;
            PG8_LDB(B1, 0, 1); PG8_STAGE(PG8_SB(0, 0), b2, voffB);
            PG8_BAR; PG8_WAIT_L(0); PG8_MMA(0, 1, At, B1); PG8_BAR;
            PG8_LDA(At, 0, 1); PG8_STAGE(PG8_SA(0, 0), a2, voffA);
            PG8_BAR; PG8_WAIT_L(0); PG8_MMA(1, 0, At, B0); PG8_BAR; PG8_SCHED;
            PG8_STAGE(PG8_SB(0, 1), b2 + hstepB, voffB);
            PG8_WAIT_V(6); PG8_BAR; PG8_MMA(1, 1, At, B1); PG8_BAR;
            PG8_LDB(B0, 1, 0); PG8_SCHED; PG8_LDA(At, 1, 0); PG8_STAGE(PG8_SA(0, 1), a2 + hstepA, voffA);
            PG8_WAIT_L(8); PG8_BAR; PG8_WAIT_L(0); PG8_MMA(0, 0, At, B0); PG8_BAR; PG8_SCHED;
            PG8_LDB(B1, 1, 1); PG8_STAGE(PG8_SB(1, 0), b3, voffB);
            PG8_BAR; PG8_WAIT_L(0); PG8_MMA(0, 1, At, B1); PG8_BAR;
            PG8_LDA(At, 1, 1); PG8_STAGE(PG8_SA(1, 0), a3, voffA);
            PG8_BAR; PG8_WAIT_L(0); PG8_MMA(1, 0, At, B0); PG8_BAR; PG8_SCHED;
            PG8_STAGE(PG8_SB(1, 1), b3 + hstepB, voffB);
            PG8_WAIT_V(6); PG8_BAR; PG8_MMA(1, 1, At, B1); PG8_BAR;
            }
        }
        if constexpr (ALIGN_EPI) { if (wr == 0) PG8_BAR; }
        E(acc, cur, wr, wc, fr, fq);
        if (!has_next) break;
#pragma unroll
        for (int a = 0; a < 2; ++a)
#pragma unroll
            for (int b = 0; b < 2; ++b)
#pragma unroll
                for (int m = 0; m < 4; ++m)
#pragma unroll
                    for (int n = 0; n < 2; ++n) acc[a][b][m][n] = (f32x4){0.f, 0.f, 0.f, 0.f};
        cur = nxt; cA = nA; cB = nB; ++ui;
        if constexpr (ALIGN_EPI) { if (wr == 1) PG8_BAR; }
    }
    PG8_WAIT_V(0);
    if constexpr (!ALIGN_EPI) { if (wr == 0) PG8_BAR; }
    PG8_BAR;
#undef PG8_SA
#undef PG8_SB
#undef PG8_STAGE
#undef PG8_LDA
#undef PG8_LDB
#undef PG8_MMA
#undef PG8_WAIT_V
#undef PG8_WAIT_L
#undef PG8_BAR
#undef PG8_SCHED
#undef PG8_ABASE
}
}

__device__ __forceinline__ float wave_max(float v) {
#pragma unroll
    for (int o = 1; o < 64; o <<= 1) v = fmaxf(v, __shfl_xor(v, o));
    return v;
}
__device__ __forceinline__ float wave_sum(float v) {
#pragma unroll
    for (int o = 1; o < 64; o <<= 1) v += __shfl_xor(v, o);
    return v;
}
struct Args;
constexpr int CI_IN = (DM / 64) * (INC / 64), CI_PW = 4 * (PGW / 64) * (PGW / 64), CI_WO = (DM / 64) * (DM / 64), CI_G = (DM / 64) * (DFF / 64), CI_D = (DFF / 64) * (DM / 64);
constexpr int CI_TOTAL = CI_IN + CI_PW + CI_WO + 2 * CI_G + CI_D;
constexpr int CVT_SPLIT = CI_IN + CI_PW + CI_WO + CI_G / 2;
struct CvtItem { const float* src; bf16_t* dst; const float* ks; int ldw, ldt; };
__device__ __forceinline__ void cvt_decode(int it, const Args& a, CvtItem& c);
__device__ __forceinline__ void cvt_load(const CvtItem& c, int lane, f32x4 (&va)[8], f32x4 (&vb)[8], float (&sa)[8], float (&sb)[8]) {
    const int kq = lane >> 4, nq = lane & 15;
    const float* p = c.src + (size_t)(2 * kq) * c.ldw + 4 * nq;
#pragma unroll
    for (int i = 0; i < 8; ++i) { va[i] = __builtin_nontemporal_load((const f32x4*)(p + (size_t)(8 * i) * c.ldw)); vb[i] = __builtin_nontemporal_load((const f32x4*)(p + (size_t)(8 * i + 1) * c.ldw)); }
    if (c.ks) {
#pragma unroll
        for (int i = 0; i < 8; ++i) { sa[i] = c.ks[8 * i + 2 * kq]; sb[i] = c.ks[8 * i + 2 * kq + 1]; }
    } else {
#pragma unroll
        for (int i = 0; i < 8; ++i) { sa[i] = 1.f; sb[i] = 1.f; }
    }
}
__device__ __forceinline__ void cvt_lds_write(LAS unsigned* tw, const f32x4 (&va)[8], const f32x4 (&vb)[8], const float (&sa)[8], const float (&sb)[8]) {
#pragma unroll
    for (int i = 0; i < 8; ++i)
#pragma unroll
        for (int j = 0; j < 4; ++j) tw[33 * j + 4 * i] = cvtpk(va[i][j] * sa[i], vb[i][j] * sb[i]);
}
__device__ __forceinline__ void cvt_store(const LAS unsigned* tr, const CvtItem& c, int lane) {
    bf16_t* dp = c.dst + (size_t)(lane >> 3) * c.ldt + 8 * (lane & 7);
#pragma unroll
    for (int jj = 0; jj < 8; ++jj) { u32x4 o; o.x = tr[8 * jj * 33 + 0]; o.y = tr[8 * jj * 33 + 1]; o.z = tr[8 * jj * 33 + 2]; o.w = tr[8 * jj * 33 + 3];
        *(u32x4*)(dp + (size_t)(8 * jj) * c.ldt) = o; }
}
__device__ __forceinline__ void cvt_range(const Args& a, int lo, int hi, int worker, int nworkers, LAS unsigned* T, int lane) {
    int it = lo + worker;
    f32x4 va[8], vb[8], wa[8], wb[8]; float sa[8], sb[8], ta[8], tb[8];
    CvtItem c0{}, c1{};
    if (it < hi) { cvt_decode(it, a, c0); cvt_load(c0, lane, va, vb, sa, sb); }
    if (it + nworkers < hi) { cvt_decode(it + nworkers, a, c1); cvt_load(c1, lane, wa, wb, ta, tb); }
    const int kq = lane >> 4, nq = lane & 15;
    LAS unsigned* tw = T + (4 * nq) * 33 + kq;
    const LAS unsigned* tr = T + (lane >> 3) * 33 + 4 * (lane & 7);
    while (it < hi) {
        {   CvtItem cc = c0;
            cvt_lds_write(tw, va, vb, sa, sb);
            if (it + 2 * nworkers < hi) { cvt_decode(it + 2 * nworkers, a, c0); cvt_load(c0, lane, va, vb, sa, sb); }
            cvt_store(tr, cc, lane); }
        it += nworkers; if (it >= hi) break;
        {   CvtItem cc = c1;
            cvt_lds_write(tw, wa, wb, ta, tb);
            if (it + 2 * nworkers < hi) { cvt_decode(it + 2 * nworkers, a, c1); cvt_load(c1, lane, wa, wb, ta, tb); }
            cvt_store(tr, cc, lane); }
        it += nworkers;
    }
}

struct Args { const float* in[13]; float* out; unsigned char* ws; };
__device__ __forceinline__ void cvt_decode(int it, const Args& a, CvtItem& c) {
    unsigned char* ws = a.ws; int q = it;
    if (q < CI_IN) { const int nblk = INC / 64, kb = q / nblk, nbk = q % nblk; c.src = a.in[2] + (size_t)(64 * kb) * INC + 64 * nbk; c.ldw = INC; c.dst = (bf16_t*)(ws + WS_WIN) + (size_t)(64 * nbk) * DM + 64 * kb; c.ldt = DM; c.ks = nullptr; return; } q -= CI_IN;
    if (q < CI_PW) { const int per = (PGW / 64) * (PGW / 64), grp = q / per, qq = q % per, nblk = PGW / 64, kb = qq / nblk, nbk = qq % nblk;
        c.src = a.in[6] + (size_t)grp * PGW * PGW + (size_t)(64 * kb) * PGW + 64 * nbk; c.ldw = PGW; c.dst = (bf16_t*)(ws + WS_PWT) + (size_t)(grp * PGW + 64 * nbk) * PGW + 64 * kb; c.ldt = PGW; c.ks = nullptr; return; } q -= CI_PW;
    if (q < CI_WO) { const int nblk = DM / 64, kb = q / nblk, nbk = q % nblk; c.src = a.in[8] + (size_t)(64 * kb) * DM + 64 * nbk; c.ldw = DM; c.dst = (bf16_t*)(ws + WS_WO) + (size_t)(64 * nbk) * DM + 64 * kb; c.ldt = DM; c.ks = nullptr; return; } q -= CI_WO;
    if (q < 2 * CI_G) { const int up = q >= CI_G ? 1 : 0, qq = q - up * CI_G, nblk = DFF / 64, kb = qq / nblk, nbk = qq % nblk, n0 = 64 * nbk;
        c.src = (up ? a.in[11] : a.in[10]) + (size_t)(64 * kb) * DFF + n0; c.ldw = DFF; c.dst = (bf16_t*)(ws + WS_WGU) + (size_t)((n0 >> 7) * 256 + up * 128 + (n0 & 127)) * DM + 64 * kb; c.ldt = DM; c.ks = a.in[9] + 64 * kb; return; } q -= 2 * CI_G;
    { const int nblk = DM / 64, kb = q / nblk, nbk = q % nblk; c.src = a.in[12] + (size_t)(64 * kb) * DM + 64 * nbk; c.ldw = DM; c.dst = (bf16_t*)(ws + WS_WD) + (size_t)(64 * nbk) * DFF + 64 * kb; c.ldt = DFF; c.ks = nullptr; }
}

constexpr int KROWB = 272, VROWB = 264;
__device__ __forceinline__ int crow(int reg, int h) { return (reg & 3) + 8 * (reg >> 2) + 4 * h; }

__device__ __forceinline__ unsigned attn_vload(u32x4 (&vw)[4], const bf16_t* __restrict__ QKVP, int nb, int kh, int vb, int tid) {
    const int kp = tid & 63, cgp = tid >> 6; const int kpos = (nb - 1) * 128 + vb * 128 + 2 * kp;
    const bool okv = (kpos >= 0) && (kpos < SEQ);
    const bf16_t* vp = QKVP + (size_t)(okv ? kpos : 0) * INC + VOFF + kh * HD + cgp * 16;
    vw[0] = *(const u32x4*)(vp); vw[1] = *(const u32x4*)(vp + INC); vw[2] = *(const u32x4*)(vp + 8); vw[3] = *(const u32x4*)(vp + INC + 8);
    return okv ? 0xffffffffu : 0u;
}
__device__ __forceinline__ void attn_vwrite(LAS unsigned char* Vt, const u32x4 (&vwr)[4], unsigned vmask, int tid) {
    const int kp = tid & 63, cgp = tid >> 6;
    LAS unsigned* vp = (LAS unsigned*)(Vt + (16 * cgp) * VROWB + kp * 4);
#pragma unroll
    for (int cc = 0; cc < 2; ++cc) { const u32x4 a = vwr[2 * cc] & vmask, b = vwr[2 * cc + 1] & vmask; LAS unsigned* q = vp + cc * 8 * (VROWB / 4);
        q[0 * (VROWB / 4)] = (a.x & 0xffffu) | (b.x << 16); q[1 * (VROWB / 4)] = (a.x >> 16) | (b.x & 0xffff0000u);
        q[2 * (VROWB / 4)] = (a.y & 0xffffu) | (b.y << 16); q[3 * (VROWB / 4)] = (a.y >> 16) | (b.y & 0xffff0000u);
        q[4 * (VROWB / 4)] = (a.z & 0xffffu) | (b.z << 16); q[5 * (VROWB / 4)] = (a.z >> 16) | (b.z & 0xffff0000u);
        q[6 * (VROWB / 4)] = (a.w & 0xffffu) | (b.w << 16); q[7 * (VROWB / 4)] = (a.w >> 16) | (b.w & 0xffff0000u); }
}
__device__ __forceinline__ void attn_qload(u32x4 (&qw)[8], const bf16_t* __restrict__ QKVP, int nb, int hq, int r0, int lane) {
    const bf16_t* qp = QKVP + (size_t)(nb * 128 + r0 + (lane & 31)) * INC + QOFF + hq * HD + 8 * (lane >> 5);
#pragma unroll
    for (int d0 = 0; d0 < 8; ++d0) qw[d0] = *(const u32x4*)(qp + 16 * d0);
}

__device__ __forceinline__ void attn_unit(LAS unsigned char* lds, const bf16_t* __restrict__ QKVP, bf16_t* __restrict__ MIX,
                                          const float* __restrict__ gq, const float* __restrict__ gk, const float* __restrict__ sinkl, int nb, int kh) {
    int tid = threadIdx.x; asm volatile("" : "+v"(tid));
    const int wid = __builtin_amdgcn_readfirstlane(tid >> 6);
    LAS unsigned char* Ks = lds; LAS unsigned char* Vt = lds + 384 * KROWB;
    const int hq = kh * 4 + (wid >> 1);
    u32x4 qw[8]; attn_qload(qw, QKVP, nb, hq, (wid & 1) * 64, tid & 63);
    {
        const int c = tid & 15, rr = tid >> 4;
        const f32x4 g0 = *(const f32x4*)(gk + c * 8), g1 = *(const f32x4*)(gk + c * 8 + 4);
        u32x4 kw[12];
#pragma unroll
        for (int pass = 0; pass < 12; ++pass) { const int kpos = (nb - 1) * 128 + pass * 32 + rr; const bool ok = (kpos >= 0 && kpos < SEQ);
            kw[pass] = *(const u32x4*)(QKVP + (size_t)(ok ? kpos : 0) * INC + KOFF + kh * HD + c * 8); }
#pragma unroll
        for (int pass = 0; pass < 12; ++pass) {
            const int j = pass * 32 + rr; const int kpos = (nb - 1) * 128 + j; const u32x4 w = kw[pass] & ((kpos >= 0 && kpos < SEQ) ? 0xffffffffu : 0u);
            const f32x4 a = (f32x4){bflo(w.x), bfhi(w.x), bflo(w.y), bfhi(w.y)}, b = (f32x4){bflo(w.z), bfhi(w.z), bflo(w.w), bfhi(w.w)};
            float ss = (a[0] * a[0] + a[1] * a[1]) + (a[2] * a[2] + a[3] * a[3]) + (b[0] * b[0] + b[1] * b[1]) + (b[2] * b[2] + b[3] * b[3]);
            ss += __shfl_xor(ss, 1); ss += __shfl_xor(ss, 2); ss += __shfl_xor(ss, 4); ss += __shfl_xor(ss, 8);
            const float rs = __builtin_amdgcn_rsqf(ss * (1.0f / HD) + EPS);
            const f32x4 oa = a * rs * g0, ob = b * rs * g1;
            u32x4 o; o.x = cvtpk(oa[0], oa[1]); o.y = cvtpk(oa[2], oa[3]); o.z = cvtpk(ob[0], ob[1]); o.w = cvtpk(ob[2], ob[3]);
            *(LAS u32x4*)(Ks + j * KROWB + c * 16) = o;
        }
    }
    u32x4 vw[4]; unsigned vmask = attn_vload(vw, QKVP, nb, kh, 0, tid);
    __syncthreads();
    const float slope2 = exp2f(-0.5f * (float)(hq + 1)) * LOG2E;
    const float sink2 = sinkl[hq] * LOG2E;
    float bnd;
    { const int l_ = tid & 63; const float a_ = fmaxf(fabsf(gq[l_]), fabsf(gq[l_ + 64])), b_ = fmaxf(fabsf(gk[l_]), fabsf(gk[l_ + 64]));
      bnd = wave_max(a_) * wave_max(b_) * (11.313708499f * LOG2E * 1.01f); }
    const bool use_bound = __builtin_amdgcn_readfirstlane(bnd < 45.0f ? 1 : 0) != 0;
#pragma unroll 1
    for (int qt = 0; qt < 2; ++qt) {
        int lane = tid & 63; asm volatile("" : "+v"(lane));
        const int r = lane & 31, h = lane >> 5;
        const int r0 = (wid & 1) * 64 + qt * 32;
        bf16x8 qf[8];
        {
            float ss = 0.f;
#pragma unroll
            for (int d0 = 0; d0 < 8; ++d0) {
                const float e0 = bflo(qw[d0].x), e1 = bfhi(qw[d0].x), e2 = bflo(qw[d0].y), e3 = bfhi(qw[d0].y), e4 = bflo(qw[d0].z), e5 = bfhi(qw[d0].z), e6 = bflo(qw[d0].w), e7 = bfhi(qw[d0].w);
                ss += (e0 * e0 + e1 * e1) + (e2 * e2 + e3 * e3) + (e4 * e4 + e5 * e5) + (e6 * e6 + e7 * e7); }
            ss += __shfl_xor(ss, 32);
            const float qs = __builtin_amdgcn_rsqf(ss * (1.0f / HD) + EPS) * (0.08838834764831845f * LOG2E);
#pragma unroll
            for (int d0 = 0; d0 < 8; ++d0) { const f32x4 ga = *(const f32x4*)(gq + 16 * d0 + 8 * h), gb = *(const f32x4*)(gq + 16 * d0 + 8 * h + 4);
                u32x4 o; o.x = cvtpk(bflo(qw[d0].x) * qs * ga[0], bfhi(qw[d0].x) * qs * ga[1]); o.y = cvtpk(bflo(qw[d0].y) * qs * ga[2], bfhi(qw[d0].y) * qs * ga[3]);
                o.z = cvtpk(bflo(qw[d0].z) * qs * gb[0], bfhi(qw[d0].z) * qs * gb[1]); o.w = cvtpk(bflo(qw[d0].w) * qs * gb[2], bfhi(qw[d0].w) * qs * gb[3]);
                qf[d0] = __builtin_bit_cast(bf16x8, o); }
        }
        const int hr = 4 * h - r;
        const int kt_first = (nb == 0) ? ((128 - r0 + 31) / 32 < 0 ? 0 : (128 - r0) / 32) : 0;
        const int kt_last = (nb == SEQ / 128 - 1) ? ((256 - r0) / 32 > 9 ? 9 : (256 - r0) / 32) : 9;
#define ATT_SCORES(kt_, sub_) \
        bf16x8 kf_[8]; { const LAS unsigned char* kp_ = Ks + (r0 + 32 * (kt_) + r) * KROWB + h * 16; \
            _Pragma("unroll") for (int d0 = 0; d0 < 8; ++d0) kf_[d0] = *(const LAS bf16x8*)(kp_ + d0 * 32); } \
        __builtin_amdgcn_sched_barrier(0);        \
        f32x16 s_; { const int dk_ = hr + 32 * (kt_) - 128; \
            _Pragma("unroll") for (int reg = 0; reg < 16; ++reg) s_[reg] = -slope2 * fabsf((float)(dk_ + crow(reg, 0))) - (sub_); \
            if ((kt_) == 0) { _Pragma("unroll") for (int reg = 0; reg < 16; ++reg) s_[reg] = (hr + crow(reg, 0) >= 0) ? s_[reg] : -1e30f; } \
            if ((kt_) == 8) { _Pragma("unroll") for (int reg = 0; reg < 16; ++reg) s_[reg] = (hr + crow(reg, 0) <= 0) ? s_[reg] : -1e30f; } \
            _Pragma("unroll") for (int d0 = 0; d0 < 8; ++d0) s_ = __builtin_amdgcn_mfma_f32_32x32x16_bf16(kf_[d0], qf[d0], s_, 0, 0, 0); }
        float mx = fmaxf(bnd, sink2);
        if (!use_bound) {
            mx = -1e30f;
#pragma unroll 1
            for (int kt = kt_first; kt < kt_last; ++kt) {
                ATT_SCORES(kt, 0.f)
#pragma unroll
                for (int reg = 0; reg < 16; ++reg) mx = fmaxf(mx, s_[reg]);
            }
            mx = fmaxf(mx, __shfl_xor(mx, 32)); mx = fmaxf(mx, sink2);
        }
        f32x16 o0 = {}, o1 = {}, o2 = {}, o3 = {}; float lsum = 0.f;
#pragma unroll 1
        for (int vb = 0; vb < 3; ++vb) {
            __syncthreads();
            attn_vwrite(Vt, vw, vmask, tid);
            { const int nvb = (vb == 2) ? 0 : vb + 1; if (!(qt == 1 && vb == 2)) vmask = attn_vload(vw, QKVP, nb, kh, nvb, tid); }
            __syncthreads();
            int kt_lo = (128 * vb - r0) / 32; if (kt_lo < kt_first) kt_lo = kt_first;
            int kt_hi = (128 * vb + 128 - r0) / 32; if (kt_hi > kt_last) kt_hi = kt_last;
#pragma unroll 1
            for (int kt = kt_lo; kt < kt_hi; ++kt) {
                ATT_SCORES(kt, mx)
                const int jl = r0 + 32 * kt - 128 * vb;
                u32x2 vfa[2][4], vfb[2][4];
#pragma unroll
                for (int st = 0; st < 2; ++st) { const LAS unsigned char* vbase = Vt + r * VROWB + (jl + 16 * st + 4 * h) * 2;
#pragma unroll
                    for (int dblk = 0; dblk < 4; ++dblk) { vfa[st][dblk] = *(const LAS u32x2*)(vbase + dblk * 32 * VROWB); vfb[st][dblk] = *(const LAS u32x2*)(vbase + dblk * 32 * VROWB + 16); } }
                __builtin_amdgcn_sched_barrier(0);
                float ps = 0.f;
#pragma unroll
                for (int reg = 0; reg < 16; ++reg) { s_[reg] = __builtin_amdgcn_exp2f(s_[reg]); ps += s_[reg]; }
                lsum += ps;
#pragma unroll
                for (int st = 0; st < 2; ++st) {
                    u32x4 pw; pw.x = cvtpk(s_[8 * st + 0], s_[8 * st + 1]); pw.y = cvtpk(s_[8 * st + 2], s_[8 * st + 3]); pw.z = cvtpk(s_[8 * st + 4], s_[8 * st + 5]); pw.w = cvtpk(s_[8 * st + 6], s_[8 * st + 7]);
                    const bf16x8 pa = __builtin_bit_cast(bf16x8, pw);
#define ATT_PV(ox, dblk) { const u32x4 vv_ = (u32x4){vfa[st][dblk].x, vfa[st][dblk].y, vfb[st][dblk].x, vfb[st][dblk].y}; ox = __builtin_amdgcn_mfma_f32_32x32x16_bf16(__builtin_bit_cast(bf16x8, vv_), pa, ox, 0, 0, 0); }
                    ATT_PV(o0, 0) ATT_PV(o1, 1) ATT_PV(o2, 2) ATT_PV(o3, 3)
#undef ATT_PV
                }
            }
        }
#undef ATT_SCORES
        if (qt == 0) attn_qload(qw, QKVP, nb, hq, r0 + 32, lane);
        lsum += __shfl_xor(lsum, 32);
        lsum += __builtin_amdgcn_exp2f(sink2 - mx);
        const float li = 1.0f / lsum;
        bf16_t* op = MIX + (size_t)(nb * 128 + r0 + r) * DM + hq * HD + 8 * h;
#define ATT_ST(ox, dblk) { _Pragma("unroll") for (int gp = 0; gp < 2; ++gp) { \
            const unsigned x0_ = cvtpk(ox[8 * gp + 0] * li, ox[8 * gp + 1] * li), x1_ = cvtpk(ox[8 * gp + 2] * li, ox[8 * gp + 3] * li); \
            const unsigned y0_ = cvtpk(ox[8 * gp + 4] * li, ox[8 * gp + 5] * li), y1_ = cvtpk(ox[8 * gp + 6] * li, ox[8 * gp + 7] * li); \
            const auto s0_ = __builtin_amdgcn_permlane32_swap(x0_, y0_, false, false); const auto s1_ = __builtin_amdgcn_permlane32_swap(x1_, y1_, false, false); \
            *(u32x4*)(op + (dblk) * 32 + gp * 16) = (u32x4){(unsigned)s0_[0], (unsigned)s1_[0], (unsigned)s0_[1], (unsigned)s1_[1]}; } }
        ATT_ST(o0, 0) ATT_ST(o1, 1) ATT_ST(o2, 2) ATT_ST(o3, 3)
#undef ATT_ST
    }
    __syncthreads();
}

__device__ __forceinline__ f32x4 bf4lo(const u32x4 w) { return (f32x4){bflo(w.x), bfhi(w.x), bflo(w.y), bfhi(w.y)}; }
__device__ __forceinline__ f32x4 bf4hi(const u32x4 w) { return (f32x4){bflo(w.z), bfhi(w.z), bflo(w.w), bfhi(w.w)}; }
__device__ __forceinline__ void pool_rows(const bf16_t* __restrict__ pb, bf16_t* __restrict__ ub, int grp, int blk0, int bstride, unsigned* cnt) {
    const int L = 1 << grp, W = 2 << grp; const int nsteps = (16 + W - 1 + 3) & ~3;
    for (int blk = blk0; blk < SEQ / 16; blk += bstride) {
        const int t0 = blk * 16;
        f32x4 a0 = {0.f, 0.f, 0.f, 0.f}, a1 = {0.f, 0.f, 0.f, 0.f};
#pragma unroll 4
        for (int k = 0; k < nsteps; ++k) {
            const int ta = t0 - L + k, ts = ta - W, t = ta - L + 1;
            const bool oka = (ta >= 0) && (ta < SEQ), oks = (ts >= t0 - L) && (ts >= 0) && (ts < SEQ), oko = (t >= t0) && (t < t0 + 16);
            const u32x4 wa = *(const u32x4*)(pb + (size_t)(oka ? ta : t0) * INC), wsb = *(const u32x4*)(pb + (size_t)(oks ? ts : t0) * INC), wc = *(const u32x4*)(pb + (size_t)(oko ? t : t0) * INC);
            const float ma = oka ? 1.f : 0.f, ms = oks ? 1.f : 0.f;
            a0 += bf4lo(wa) * ma - bf4lo(wsb) * ms; a1 += bf4hi(wa) * ma - bf4hi(wsb) * ms;
            if (oko) {
                const int lo = (t - L) < 0 ? 0 : (t - L), hi = (t + L) > SEQ ? SEQ : (t + L);
                const float ic = 1.0f / (float)(hi - lo);
                const f32x4 u0 = a0 * ic - bf4lo(wc), u1 = a1 * ic - bf4hi(wc);
                u32x4 o; o.x = cvtpk(u0[0], u0[1]); o.y = cvtpk(u0[2], u0[3]); o.z = cvtpk(u1[0], u1[1]); o.w = cvtpk(u1[2], u1[3]);
                if (cnt) st16_wt(ub + (size_t)t * PGW, o); else *(u32x4*)(ub + (size_t)t * PGW) = o;
            }
        }
        if (cnt) {
            asm volatile("s_waitcnt vmcnt(0)" ::: "memory");
            if ((threadIdx.x & 63) == 0) (void)__hip_atomic_fetch_add(cnt + (t0 >> 8) * 4 + grp, 1u, __ATOMIC_RELAXED, __HIP_MEMORY_SCOPE_AGENT);
        }
    }
}

#define XB_TMO      128
#define XB_XCNT(j)  (256  + 64 * (j))
#define XB_XSUB(j)  (1280 + 64 * (j))
#define XB_XGEN(j)  (2304 + 64 * (j))
#define XB_TOP      3328
#define XB_TOPGEN   3392
#define XCD_BAR_WORDS 3456
#define XB_SPIN_CAP (1u << 18)
__device__ __forceinline__ unsigned xb_ld(unsigned* p)              { return __hip_atomic_load(p, __ATOMIC_RELAXED, __HIP_MEMORY_SCOPE_AGENT); }
__device__ __forceinline__ unsigned xb_add(unsigned* p, unsigned v) { return __hip_atomic_fetch_add(p, v, __ATOMIC_RELAXED, __HIP_MEMORY_SCOPE_AGENT); }
__device__ __forceinline__ unsigned xb_xcc_id() { return (unsigned)__builtin_amdgcn_s_getreg((3 << 11) | 20) & 0xFu; }
#define XB_SPIN(cond, bar) do { unsigned _sp = 0; while (cond) { __builtin_amdgcn_s_sleep(1); \
    if ((++_sp & 255u) == 0u) { if (xb_ld(&(bar)[XB_TMO])) break; if (_sp > XB_SPIN_CAP) { atomicAdd(&(bar)[XB_TMO], 1u); break; } } } } while (0)
struct XcdBarrier { unsigned* bar; unsigned x; volatile LAS unsigned* st; };
__device__ __forceinline__ XcdBarrier xcd_barrier_post(unsigned* bar, volatile LAS unsigned* st) {
    XcdBarrier b; b.bar = bar; b.x = xb_xcc_id(); b.st = st;
    if (threadIdx.x == 0) (void)xb_add(&bar[XB_XCNT(b.x)], 1u);
    return b;
}
__device__ __forceinline__ void xcd_barrier_complete(unsigned* bar, unsigned x, unsigned& nloc, unsigned& nx) {
    const unsigned G = gridDim.x * gridDim.y * gridDim.z;
    unsigned sum, cnt, mine, sp = 0u;
    for (;;) {
        sum = 0u; cnt = 0u; mine = 0u;
#pragma unroll
        for (unsigned j = 0; j < 16; ++j) { const unsigned c = xb_ld(&bar[XB_XCNT(j)]); sum += c; cnt += (c > 0u) ? 1u : 0u; mine = (j == x) ? c : mine; }
        if (sum == G) break;
        __builtin_amdgcn_s_sleep(1);
        if ((++sp & 255u) == 0u) { if (xb_ld(&bar[XB_TMO])) break; if (sp > XB_SPIN_CAP) { atomicAdd(&bar[XB_TMO], 1u); break; } }
    }
    nloc = mine > 0u ? mine : 1u; nx = cnt > 0u ? cnt : 1u;
}
__device__ __forceinline__ void xcd_barrier(const XcdBarrier& b) {
    asm volatile("s_waitcnt vmcnt(0)" ::: "memory");
    __syncthreads();
    if (threadIdx.x == 0) {
        unsigned* bar = b.bar;
        __builtin_amdgcn_s_waitcnt(0);
        unsigned nloc = b.st[0], nx = b.st[1];
        if (nloc == 0u) { xcd_barrier_complete(bar, b.x, nloc, nx); b.st[0] = nloc; b.st[1] = nx; }
        const unsigned old = xb_add(&bar[XB_XSUB(b.x)], 1u);
        const unsigned gen = old / nloc;
        if (old + 1u == (gen + 1u) * nloc) {
            __builtin_amdgcn_fence(__ATOMIC_RELEASE, "agent");
            asm volatile("s_waitcnt vmcnt(0)" ::: "memory");
            const unsigned og = xb_add(&bar[XB_TOP], 1u);
            const unsigned tg = og / nx;
            if (og + 1u == (tg + 1u) * nx) xb_add(&bar[XB_TOPGEN], 1u);
            else XB_SPIN(xb_ld(&bar[XB_TOPGEN]) == tg, bar);
            __builtin_amdgcn_fence(__ATOMIC_ACQUIRE, "agent");
            xb_add(&bar[XB_XGEN(b.x)], 1u);
            asm volatile("s_waitcnt vmcnt(0)" ::: "memory");
        } else {
            XB_SPIN(xb_ld(&bar[XB_XGEN(b.x)]) == gen, bar);
            __builtin_amdgcn_fence(__ATOMIC_ACQUIRE, "agent");
            asm volatile("s_waitcnt vmcnt(0)" ::: "memory");
        }
    }
    __syncthreads();
}

__global__ void __launch_bounds__(NWAVES * 64, 2) fwd_kernel(Args args) {
    extern __shared__ __attribute__((aligned(16))) unsigned char lds_raw[];
    LAS unsigned char* lds = (LAS unsigned char*)lds_raw;
    cg::grid_group grid = cg::this_grid();
    const int tid = threadIdx.x, lane = tid & 63, wave = __builtin_amdgcn_readfirstlane(tid >> 6);
    const int G = gridDim.x, bid = blockIdx.x;
    const int gw = bid * NWAVES + wave, NGW = G * NWAVES;
    const bool split_roles = (G == 256);
    unsigned char* ws = args.ws;
    volatile LAS unsigned* bst = (volatile LAS unsigned*)(lds + LDS_MISC);
    if (tid == 0) { bst[0] = 0u; bst[1] = 0u; }
    __syncthreads();
    const XcdBarrier xbar = xcd_barrier_post((unsigned*)(ws + WS_CTL), bst);
    const float* x = args.in[0]; const float* norm1_g = args.in[1]; const float* w_in = args.in[2]; const float* q_norm_g = args.in[3]; const float* k_norm_g = args.in[4];
    const float* sink_logits = args.in[5]; const float* pool_w = args.in[6]; const float* pool_scale = args.in[7]; const float* w_out = args.in[8]; const float* norm2_g = args.in[9];
    const float* w_gate = args.in[10]; const float* w_up = args.in[11]; const float* w_down = args.in[12];
    float* out = args.out;
    bf16_t* WinT = (bf16_t*)(ws + WS_WIN); bf16_t* PwT = (bf16_t*)(ws + WS_PWT); bf16_t* WoT = (bf16_t*)(ws + WS_WO); bf16_t* WguT = (bf16_t*)(ws + WS_WGU); bf16_t* WdT = (bf16_t*)(ws + WS_WD);
    bf16_t* XN = (bf16_t*)(ws + WS_XN); float* SSQ = (float*)(ws + WS_SSQ); bf16_t* QKVP = (bf16_t*)(ws + WS_QKVP); bf16_t* MIX = (bf16_t*)(ws + WS_MIX); bf16_t* U = (bf16_t*)(ws + WS_U); bf16_t* Hb = (bf16_t*)(ws + WS_H);

    {
        cvt_range(args, 0, split_roles ? CVT_SPLIT : CI_TOTAL, gw, NGW, (LAS unsigned*)(lds + wave * 16384), lane);
        for (int m = gw; m < SEQ; m += NGW) {
            const f32x4* xr = (const f32x4*)(x + (size_t)m * DM) + lane; const f32x4* gr = (const f32x4*)norm1_g + lane;
            f32x4 v[16]; float s = 0.f;
#pragma unroll
            for (int j = 0; j < 16; ++j) { v[j] = __builtin_nontemporal_load(xr + 64 * j); s += (v[j][0] * v[j][0] + v[j][1] * v[j][1]) + (v[j][2] * v[j][2] + v[j][3] * v[j][3]); }
            const float rstd = __builtin_amdgcn_rsqf(wave_sum(s) * (1.0f / DM) + EPS);
            u32x2* o8 = (u32x2*)(XN + (size_t)m * DM) + lane;
#pragma unroll
            for (int j = 0; j < 16; ++j) { const f32x4 gg = gr[64 * j]; const f32x4 y = v[j] * rstd * gg; u32x2 w; w.x = cvtpk(y[0], y[1]); w.y = cvtpk(y[2], y[3]); o8[64 * j] = w; }
        }
    }
    if (ws == nullptr) grid.sync();
    xcd_barrier(xbar);

    {
        if (!split_roles || bid < P1_GEMM_CUS) {
            pg8::Gemm g{XN, WinT, DM, DM, DM, 0, 0}; pg8::StaticOrder S; S.init(SEQ, INC, split_roles ? P1_GEMM_CUS : G, bid);
            pg8::EpiStore E{QKVP, INC};
            pg8::gemm_phase<pg8::EpiStore, true>(lds, g, S, E);
        } else {
            cvt_range(args, CVT_SPLIT, CI_TOTAL - CI_D, (bid - P1_GEMM_CUS) * NWAVES + wave, (G - P1_GEMM_CUS) * NWAVES, (LAS unsigned*)(lds + wave * 16384), lane);
        }
    }
    xcd_barrier(xbar);

    if (G == 256) {
        unsigned* pcnt = (unsigned*)(ws + WS_CTL + 14400);
        {
            const int grp = gw & 3; const bf16_t* pb = QKVP + POFF + grp * PGW + lane * 8; bf16_t* ub = U + (size_t)grp * SEQ * PGW + lane * 8;
            pool_rows(pb, ub, grp, gw >> 2, NGW >> 2, pcnt);
        }
        {
            pg8::Gemm g{U, PwT, PGW, PGW, PGW, (long)SEQ * PGW, 1}; pg8::StaticOrder S; S.init(SEQ, PW, G, bid);
            pg8::Unit u0;
            if (S.next(0, u0) && wave == 0) {
                unsigned* c = pcnt + u0.pm * 4 + (u0.pn >> 1); unsigned spins = 0;
                while ((unsigned)__builtin_amdgcn_readfirstlane(__hip_atomic_load(c, __ATOMIC_RELAXED, __HIP_MEMORY_SCOPE_AGENT)) < 16u) { __builtin_amdgcn_s_sleep(2); if (++spins > (1u << 22)) break; }
                __builtin_amdgcn_fence(__ATOMIC_ACQUIRE, "agent");
                asm volatile("s_waitcnt vmcnt(0)" ::: "memory");
            }
            __syncthreads();
            pg8::EpiPool E{MIX, DM, PW, pool_scale};
            pg8::gemm_phase<pg8::EpiPool, true>(lds, g, S, E);
        }
        for (int un = bid; un < (SEQ / 128) * NKV; un += G) attn_unit(lds, QKVP, MIX, q_norm_g, k_norm_g, sink_logits, un >> 2, un & 3);
    } else {
        for (int un = bid; un < (SEQ / 128) * NKV; un += G) attn_unit(lds, QKVP, MIX, q_norm_g, k_norm_g, sink_logits, un >> 2, un & 3);
        {
            const int grp = gw & 3; const bf16_t* pb = QKVP + POFF + grp * PGW + lane * 8; bf16_t* ub = U + (size_t)grp * SEQ * PGW + lane * 8;
            pool_rows(pb, ub, grp, gw >> 2, NGW >> 2, nullptr);
        }
        xcd_barrier(xbar);
        pg8::Gemm g{U, PwT, PGW, PGW, PGW, (long)SEQ * PGW, 1}; pg8::StaticOrder S; S.init(SEQ, PW, G, bid);
        pg8::EpiPool E{MIX, DM, PW, pool_scale};
        pg8::gemm_phase<pg8::EpiPool, true>(lds, g, S, E);
    }
    xcd_barrier(xbar);

    {
        pg8::Gemm g{MIX, WoT, DM, DM, DM, 0, 0}; pg8::StaticOrder S; S.init(SEQ, DM, G, bid);
        pg8::EpiWout E{x, XN, SSQ};
        pg8::gemm_phase<pg8::EpiWout, true>(lds, g, S, E);
    }
    xcd_barrier(xbar);

    {
        pg8::Gemm g{XN, WguT, DM, DM, DM, 0, 0}; pg8::StaticOrder S; S.init(SEQ, 2 * DFF, G, bid);
        LAS float* rstd_lds = (LAS float*)(lds + pg8::STAGE_BYTES);
        int pm_cached = -1;
        { pg8::Unit u0; if (S.next(0, u0)) { pm_cached = u0.pm;
            const int rowl = tid >> 1, hf = tid & 1; const f32x4* sp = (const f32x4*)(SSQ + (size_t)(pm_cached * 256 + rowl) * 64 + hf * 32);
            float sacc = 0.f;
#pragma unroll
            for (int q = 0; q < 8; ++q) { const f32x4 v = sp[q]; sacc += (v[0] + v[1]) + (v[2] + v[3]); }
            sacc += __shfl_xor(sacc, 1);
            if (hf == 0) rstd_lds[rowl] = __builtin_amdgcn_rsqf(sacc * (1.0f / DM) + EPS); } }
        __syncthreads();
        pg8::EpiGateUp E{Hb, SSQ, rstd_lds, pm_cached};
        pg8::gemm_phase<pg8::EpiGateUp, true>(lds, g, S, E);
        {
            const int nunits = (SEQ / 256) * (2 * DFF / 256), nfull = nunits % G;
            if (!split_roles) {}
            else if (nfull != 0 && bid >= nfull) cvt_range(args, CI_TOTAL - CI_D, CI_TOTAL, (bid - nfull) * NWAVES + wave, (G - nfull) * NWAVES, (LAS unsigned*)(lds + wave * 16384), lane);
            else if (nfull == 0) cvt_range(args, CI_TOTAL - CI_D, CI_TOTAL, gw, NGW, (LAS unsigned*)(lds + wave * 16384), lane);
        }
    }
    xcd_barrier(xbar);

    {
        pg8::Gemm g{Hb, WdT, DFF, DFF, DFF, 0, 0}; pg8::StaticOrder S; S.init(SEQ, DM, G, bid);
        pg8::EpiDown E{out, XN};
        pg8::gemm_phase<pg8::EpiDown, true>(lds, g, S, E);
    }
}

extern "C" void kernel_launch(void* const* d_in, const int* in_sizes, int n_in, void* d_out, int out_size, void* d_ws, size_t ws_size, hipStream_t stream) {
    static int grid = 0;
    if (grid == 0) {
        if (n_in != 13 || out_size != SEQ * DM || ws_size < WS_END) { fprintf(stderr, "kernel_launch: unexpected shapes (n_in %d out %d ws %zu)\n", n_in, out_size, ws_size); grid = -1; return; }
        int dev = 0, cus = 0, per_cu = 0;
        if (hipGetDevice(&dev) != hipSuccess || hipDeviceGetAttribute(&cus, hipDeviceAttributeMultiprocessorCount, dev) != hipSuccess) { grid = -1; return; }
        if (hipFuncSetAttribute((const void*)fwd_kernel, hipFuncAttributeMaxDynamicSharedMemorySize, LDS_BYTES) != hipSuccess) { fprintf(stderr, "kernel_launch: hipFuncSetAttribute failed\n"); grid = -1; return; }
        if (hipOccupancyMaxActiveBlocksPerMultiprocessor(&per_cu, (const void*)fwd_kernel, NWAVES * 64, LDS_BYTES) != hipSuccess || per_cu < 1) { fprintf(stderr, "kernel_launch: occupancy query gave %d\n", per_cu); per_cu = 1; }
        (void)hipGetLastError();
        grid = cus * 1;
    }
    if (grid < 0) return;
    Args a{};
    for (int i = 0; i < 13; ++i) a.in[i] = (const float*)d_in[i];
    a.out = (float*)d_out; a.ws = (unsigned char*)d_ws;
    if (hipMemsetAsync((char*)d_ws + WS_CTL, 0, CTL_BYTES, stream) != hipSuccess) { fprintf(stderr, "kernel_launch: memset of the barrier words failed\n"); return; }
    void* kargs[] = {&a};
    hipError_t e = hipLaunchCooperativeKernel((const void*)fwd_kernel, dim3(grid), dim3(NWAVES * 64), kargs, LDS_BYTES, stream);
    if (e != hipSuccess) fprintf(stderr, "kernel_launch: cooperative launch failed: %s (grid %d)\n", hipGetErrorString(e), grid);
}
```

```cpp
#include <hip/hip_runtime.h>
#include <hip/hip_cooperative_groups.h>
#include <cstdio>
#include <cstdint>
namespace cg = cooperative_groups;

#define LAS __attribute__((address_space(3)))
typedef unsigned short bf16_t;
typedef short bf16x8 __attribute__((ext_vector_type(8)));
typedef float f32x4 __attribute__((ext_vector_type(4)));
typedef float f32x16 __attribute__((ext_vector_type(16)));
typedef unsigned u32x4 __attribute__((ext_vector_type(4)));
typedef unsigned u32x2 __attribute__((ext_vector_type(2)));
typedef float f32x2_t __attribute__((ext_vector_type(2)));
typedef __bf16 bf16x2_t __attribute__((ext_vector_type(2)));

constexpr int SEQ = 8192, DM = 4096, HD = 128, NH = 16, NKV = 4, INC = 5120, DFF = 11008, PW = 2048, PGW = 512;
constexpr int QOFF = 0, KOFF = 2048, VOFF = 2560, POFF = 3072;
constexpr float EPS = 1e-6f;
constexpr float LOG2E = 1.4426950408889634f;

constexpr size_t MiB = 1u << 20;
constexpr size_t WS_WIN = 0 * MiB;
constexpr size_t WS_PWT = 40 * MiB;
constexpr size_t WS_WO = 42 * MiB;
constexpr size_t WS_WGU = 74 * MiB;
constexpr size_t WS_WD = 246 * MiB;
constexpr size_t WS_XN = 332 * MiB;
constexpr size_t WS_SSQ = 396 * MiB;
constexpr size_t WS_QKVP = 398 * MiB;
constexpr size_t WS_MIX = 478 * MiB;
constexpr size_t WS_U = 542 * MiB;
constexpr size_t WS_H = 398 * MiB;
constexpr size_t WS_CTL = 574 * MiB;
constexpr size_t CTL_BYTES = 16384;
constexpr size_t WS_END = 575 * MiB;

constexpr int LDS_BYTES = 147456;
constexpr int LDS_MISC = LDS_BYTES - 64;
constexpr int NWAVES = 8;
constexpr int P1_GEMM_CUS = 216;

__device__ __forceinline__ unsigned cvtpk(float lo, float hi) { f32x2_t v = {lo, hi}; bf16x2_t b = __builtin_convertvector(v, bf16x2_t); return __builtin_bit_cast(unsigned, b); }
__device__ __forceinline__ float bflo(unsigned w) { return __uint_as_float(w << 16); }
__device__ __forceinline__ float bfhi(unsigned w) { return __uint_as_float(w & 0xffff0000u); }

#ifndef PG8_SP2_DEFAULT
#define PG8_SP2_DEFAULT true
#endif
namespace pg8 {
constexpr int BM = 256, BK = 64, HALF = 128, HTB = HALF * BK * 2, STAGE_BYTES = 8 * HTB, NXCD = 8, WGM = 8;
__host__ __device__ __forceinline__ int lds_byte(int r, int c) { const int st = (r >> 4) * 2 + (c >> 5), rr = r & 15, cc = c & 31, ob = rr * 64 + cc * 2; return st * 1024 + (ob ^ (((ob >> 9) & 1) << 5)); }
__host__ __device__ __forceinline__ void stage_rc(int b, int& R, int& C) { const int st = b / 1024, sb = b % 1024, swz = sb ^ (((sb >> 9) & 1) << 5); R = (st >> 1) * 16 + swz / 64; C = (st & 1) * 32 + (swz % 64) / 2; }
__host__ __device__ __forceinline__ int perm32(int rho) { const int n = rho >> 4, i = rho & 15; return 8 * (i >> 2) + 4 * n + (i & 3); }

struct Unit { int pm, pn; };
struct Gemm { const bf16_t* A; const bf16_t* Bt; int lda, ldb, K; long a_grp_stride; int a_grp_shift; };

struct StaticOrder {
    int nM, nN, nwg, G, c;
    __device__ void init(int M, int N, int G_, int c_) { nM = M / BM; nN = N / BM; nwg = nM * nN; G = G_; c = c_; }
    __device__ bool next(int i, Unit& u) const {
        const long L = (long)i * G + c; if (L >= nwg) return false;
        int wgid = (int)L; { const int q = nwg / NXCD, r = nwg % NXCD, xcd = wgid % NXCD, off = wgid / NXCD; wgid = (xcd < r ? xcd * (q + 1) : r * (q + 1) + (xcd - r) * q) + off; }
        const int nig = WGM * nN, gid = wgid / nig, fm = gid * WGM, gsz = (nM - fm) < WGM ? (nM - fm) : WGM;
        u.pm = fm + ((wgid % nig) % gsz); u.pn = (wgid % nig) / gsz; return true;
    }
};


struct EpiStore {
    bf16_t* O; int ldc;
    __device__ __forceinline__ void operator()(const f32x4 (&acc)[2][2][4][2], const Unit& u, int wr, int wc, int fr, int fq) const {
        const int row0 = u.pm * BM + wr * 64 + fr, col0 = u.pn * BM + wc * 32 + 8 * fq;
#pragma unroll
        for (int ai = 0; ai < 2; ++ai)
#pragma unroll
            for (int m = 0; m < 4; ++m) { bf16_t* rowp = O + (size_t)(row0 + ai * HALF + m * 16) * ldc + col0;
#pragma unroll
                for (int bj = 0; bj < 2; ++bj) { const f32x4 v0 = acc[ai][bj][m][0], v1 = acc[ai][bj][m][1];
                    u32x4 w; w.x = cvtpk(v0[0], v0[1]); w.y = cvtpk(v0[2], v0[3]); w.z = cvtpk(v1[0], v1[1]); w.w = cvtpk(v1[2], v1[3]);
                    *(u32x4*)(rowp + bj * HALF) = w; } }
    }
};
struct EpiPool {
    bf16_t* O; int ldc; int coloff; const float* scale;
    __device__ __forceinline__ void operator()(const f32x4 (&acc)[2][2][4][2], const Unit& u, int wr, int wc, int fr, int fq) const {
        const int row0 = u.pm * BM + wr * 64 + fr, col0 = u.pn * BM + wc * 32 + 8 * fq;
        f32x4 sv[2][2];
#pragma unroll
        for (int bj = 0; bj < 2; ++bj)
#pragma unroll
            for (int n = 0; n < 2; ++n) sv[bj][n] = *(const f32x4*)(scale + col0 + bj * HALF + 4 * n);
#pragma unroll
        for (int ai = 0; ai < 2; ++ai)
#pragma unroll
            for (int m = 0; m < 4; ++m) { bf16_t* rowp = O + (size_t)(row0 + ai * HALF + m * 16) * ldc + coloff + col0;
#pragma unroll
                for (int bj = 0; bj < 2; ++bj) { const f32x4 v0 = acc[ai][bj][m][0] * sv[bj][0], v1 = acc[ai][bj][m][1] * sv[bj][1];
                    u32x4 w; w.x = cvtpk(v0[0], v0[1]); w.y = cvtpk(v0[2], v0[3]); w.z = cvtpk(v1[0], v1[1]); w.w = cvtpk(v1[2], v1[3]);
                    *(u32x4*)(rowp + bj * HALF) = w; } }
    }
};
struct EpiWout {
    const float* X; bf16_t* xb; float* ssq;
    __device__ __forceinline__ void operator()(const f32x4 (&acc)[2][2][4][2], const Unit& u, int wr, int wc, int fr, int fq) const {
        const int row0 = u.pm * BM + wr * 64 + fr, col0 = u.pn * BM + wc * 32 + 8 * fq;
#pragma unroll
        for (int ai = 0; ai < 2; ++ai)
#pragma unroll
            for (int m = 0; m < 4; ++m) { const int row = row0 + ai * HALF + m * 16; const size_t off = (size_t)row * DM + col0; float s = 0.f;
#pragma unroll
                for (int bj = 0; bj < 2; ++bj) {
                    const f32x4 x0 = __builtin_nontemporal_load((const f32x4*)(X + off + bj * HALF)), x1 = __builtin_nontemporal_load((const f32x4*)(X + off + bj * HALF + 4));
                    const f32x4 v0 = acc[ai][bj][m][0] + x0, v1 = acc[ai][bj][m][1] + x1;
                    u32x4 w; w.x = cvtpk(v0[0], v0[1]); w.y = cvtpk(v0[2], v0[3]); w.z = cvtpk(v1[0], v1[1]); w.w = cvtpk(v1[2], v1[3]);
                    *(u32x4*)(xb + off + bj * HALF) = w;
                    s += (v0[0] * v0[0] + v0[1] * v0[1]) + (v0[2] * v0[2] + v0[3] * v0[3]) + (v1[0] * v1[0] + v1[1] * v1[1]) + (v1[2] * v1[2] + v1[3] * v1[3]); }
                s += __shfl_xor(s, 16); s += __shfl_xor(s, 32);
                if (fq == 0) ssq[(size_t)row * 64 + u.pn * 4 + wc] = s; }
    }
};
struct EpiGateUp {
    bf16_t* H; const float* ssq; const LAS float* rstd_lds; int pm_cached;
    __device__ __forceinline__ void operator()(const f32x4 (&acc)[2][2][4][2], const Unit& u, int wr, int wc, int fr, int fq) const {
        const int row0 = u.pm * BM + wr * 64 + fr, col0 = u.pn * HALF + wc * 32 + 8 * fq;
        const bool cached = (u.pm == pm_cached);
#pragma unroll
        for (int ai = 0; ai < 2; ++ai)
#pragma unroll
            for (int m = 0; m < 4; ++m) { const int row = row0 + ai * HALF + m * 16;
                float rstd;
                if (cached) rstd = rstd_lds[row - u.pm * BM];
                else {
                    const f32x4* sp = (const f32x4*)(ssq + (size_t)row * 64 + fq * 16);
                    const f32x4 a = sp[0], b = sp[1], c = sp[2], d = sp[3];
                    float s = ((a[0] + a[1]) + (a[2] + a[3])) + ((b[0] + b[1]) + (b[2] + b[3])) + ((c[0] + c[1]) + (c[2] + c[3])) + ((d[0] + d[1]) + (d[2] + d[3]));
                    s += __shfl_xor(s, 16); s += __shfl_xor(s, 32);
                    rstd = __builtin_amdgcn_rsqf(s * (1.0f / DM) + EPS);
                }
                float hv[8];
#pragma unroll
                for (int n = 0; n < 2; ++n)
#pragma unroll
                    for (int i = 0; i < 4; ++i) { const float g = acc[ai][0][m][n][i] * rstd, up = acc[ai][1][m][n][i] * rstd;
                        hv[4 * n + i] = g * __builtin_amdgcn_rcpf(1.0f + __expf(-g)) * up; }
                u32x4 w; w.x = cvtpk(hv[0], hv[1]); w.y = cvtpk(hv[2], hv[3]); w.z = cvtpk(hv[4], hv[5]); w.w = cvtpk(hv[6], hv[7]);
                *(u32x4*)(H + (size_t)row * DFF + col0) = w; }
    }
};
struct EpiDown {
    float* out; const bf16_t* xb;
    __device__ __forceinline__ void operator()(const f32x4 (&acc)[2][2][4][2], const Unit& u, int wr, int wc, int fr, int fq) const {
        const int row0 = u.pm * BM + wr * 64 + fr, col0 = u.pn * BM + wc * 32 + 8 * fq;
#pragma unroll
        for (int ai = 0; ai < 2; ++ai)
#pragma unroll
            for (int m = 0; m < 4; ++m) { const size_t off = (size_t)(row0 + ai * HALF + m * 16) * DM + col0;
#pragma unroll
                for (int bj = 0; bj < 2; ++bj) {
                    const u32x4 xw = *(const u32x4*)(xb + off + bj * HALF);
                    const f32x4 x0 = (f32x4){bflo(xw.x), bfhi(xw.x), bflo(xw.y), bfhi(xw.y)}, x1 = (f32x4){bflo(xw.z), bfhi(xw.z), bflo(xw.w), bfhi(xw.w)};
                    __builtin_nontemporal_store(acc[ai][bj][m][0] + x0, (f32x4*)(out + off + bj * HALF)); __builtin_nontemporal_store(acc[ai][bj][m][1] + x1, (f32x4*)(out + off + bj * HALF + 4)); } }
    }
};

template <class Epi, bool ALIGN_EPI, bool SP2 = PG8_SP2_DEFAULT>
__device__ __forceinline__ void gemm_phase(LAS unsigned char* lds, const Gemm g, const StaticOrder& S, const Epi& E) {
    int tid = threadIdx.x; asm volatile("" : "+v"(tid));
    const int wid = __builtin_amdgcn_readfirstlane(tid >> 6), lane = tid & 63, wr = wid >> 2, wc = wid & 3, fr = lane & 15, fq = lane >> 4;
    const int K = g.K, nt = K / BK;
    unsigned voffA[2], voffB[2];
#pragma unroll
    for (int i = 0; i < 2; ++i) { int R, C; stage_rc(tid * 16 + i * 8192, R, C); const int Rb = (R & ~31) + perm32(R & 31);
        voffA[i] = (unsigned)(R * g.lda + C) * 2u; voffB[i] = (unsigned)(Rb * g.ldb + C) * 2u; }
    const size_t kstep = (size_t)(BK * 2);
    const size_t hstepA = (size_t)HALF * g.lda * 2, hstepB = (size_t)HALF * g.ldb * 2;
    const size_t tstepA = 2 * hstepA, tstepB = 2 * hstepB;
    const unsigned ldsw = (unsigned)wid * 1024u;
    const int aoff = lds_byte(wr * 64 + fr, fq * 8), boff = lds_byte(wc * 32 + fr, fq * 8);
#define PG8_SA(b, h) (((b) * 2 + (h)) * HTB)
#define PG8_SB(b, h) ((4 + (b) * 2 + (h)) * HTB)
#define PG8_STAGE(bufoff, gbase, voff) do { _Pragma("unroll") for (int _i = 0; _i < 2; ++_i) \
        __builtin_amdgcn_global_load_lds((const unsigned*)((const char*)(gbase) + (voff)[_i]), (LAS unsigned*)(lds + (bufoff) + ldsw + _i * 8192), 16, 0, 0); } while (0)
#define PG8_LDA(dst, b, h) do { _Pragma("unroll") for (int m = 0; m < 4; ++m) _Pragma("unroll") for (int k = 0; k < 2; ++k) dst[m][k] = *(const LAS bf16x8*)(lds + PG8_SA(b, h) + aoff + m * 2048 + k * 1024); } while (0)
#define PG8_LDB(dst, b, h) do { _Pragma("unroll") for (int n = 0; n < 2; ++n) _Pragma("unroll") for (int k = 0; k < 2; ++k) dst[n][k] = *(const LAS bf16x8*)(lds + PG8_SB(b, h) + boff + n * 2048 + k * 1024); } while (0)
#define PG8_MMA(ai, bj, At, Bt) do { __builtin_amdgcn_s_setprio(1); _Pragma("unroll") for (int m = 0; m < 4; ++m) _Pragma("unroll") for (int n = 0; n < 2; ++n) _Pragma("unroll") for (int k = 0; k < 2; ++k) \
        acc[ai][bj][m][n] = __builtin_amdgcn_mfma_f32_16x16x32_bf16(Bt[n][k], At[m][k], acc[ai][bj][m][n], 0, 0, 0); __builtin_amdgcn_s_setprio(0); } while (0)
#define PG8_WAIT_V(n) asm volatile("s_waitcnt vmcnt(" #n ")" ::: "memory")
#define PG8_WAIT_L(n) asm volatile("s_waitcnt lgkmcnt(" #n ")" ::: "memory")
#define PG8_BAR __builtin_amdgcn_s_barrier()
#define PG8_SCHED __builtin_amdgcn_sched_barrier(0)
#define PG8_ABASE(u) ((const char*)g.A + ((size_t)((u).pn >> g.a_grp_shift) * (size_t)g.a_grp_stride) * 2 + (size_t)(u).pm * tstepA)
    Unit cur, nxt; int ui = 0;
    if (!S.next(0, cur)) return;
    f32x4 acc[2][2][4][2];
#pragma unroll
    for (int a = 0; a < 2; ++a)
#pragma unroll
        for (int b = 0; b < 2; ++b)
#pragma unroll
            for (int m = 0; m < 4; ++m)
#pragma unroll
                for (int n = 0; n < 2; ++n) acc[a][b][m][n] = (f32x4){0.f, 0.f, 0.f, 0.f};
    bf16x8 At[4][2], B0[2][2], B1[2][2];
    const char* cA = PG8_ABASE(cur); const char* cB = (const char*)g.Bt + (size_t)cur.pn * tstepB;
    if constexpr (SP2) {
    PG8_STAGE(PG8_SB(0, 0), cB, voffB); PG8_STAGE(PG8_SB(0, 1), cB + hstepB, voffB); PG8_STAGE(PG8_SA(0, 0), cA, voffA); PG8_STAGE(PG8_SA(0, 1), cA + hstepA, voffA);
    if (wr == 1) PG8_BAR;
    PG8_WAIT_V(2); PG8_BAR;
    PG8_STAGE(PG8_SB(1, 0), cB + kstep, voffB); PG8_STAGE(PG8_SA(1, 0), cA + kstep, voffA); PG8_STAGE(PG8_SB(1, 1), cB + hstepB + kstep, voffB);
    PG8_WAIT_V(6); PG8_BAR;
    } else {
    PG8_STAGE(PG8_SB(0, 0), cB, voffB); PG8_STAGE(PG8_SA(0, 0), cA, voffA); PG8_STAGE(PG8_SB(0, 1), cB + hstepB, voffB); PG8_STAGE(PG8_SA(0, 1), cA + hstepA, voffA);
    if (wr == 1) PG8_BAR;
    PG8_WAIT_V(4); PG8_BAR;
    PG8_STAGE(PG8_SB(1, 0), cB + kstep, voffB); PG8_STAGE(PG8_SA(1, 0), cA + kstep, voffA); PG8_STAGE(PG8_SB(1, 1), cB + hstepB + kstep, voffB);
    PG8_WAIT_V(6); PG8_BAR;
    }
    for (;;) {
        const bool has_next = S.next(ui + 1, nxt);
        const char* nA = has_next ? PG8_ABASE(nxt) : cA; const char* nB = has_next ? (const char*)g.Bt + (size_t)nxt.pn * tstepB : cB;
        for (int t = 0; t < nt; t += 2) {
            const bool last = (t == nt - 2);
            const char* a1 = cA + (size_t)(t + 1) * kstep;
            const char* a2 = last ? nA : cA + (size_t)(t + 2) * kstep; const char* b2 = last ? nB : cB + (size_t)(t + 2) * kstep;
            const char* a3 = a2 + kstep; const char* b3 = b2 + kstep;
            if constexpr (SP2) {
            PG8_LDB(B0, 0, 0); PG8_LDB(B1, 0, 1); PG8_SCHED; PG8_LDA(At, 0, 0); PG8_STAGE(PG8_SA(1, 1), a1 + hstepA, voffA);
            PG8_WAIT_V(8); PG8_WAIT_L(0); PG8_BAR; PG8_MMA(0, 0, At, B0); PG8_MMA(0, 1, At, B1); PG8_BAR; PG8_SCHED;
            PG8_LDA(At, 0, 1); PG8_STAGE(PG8_SB(0, 0), b2, voffB); PG8_STAGE(PG8_SB(0, 1), b2 + hstepB, voffB); PG8_STAGE(PG8_SA(0, 0), a2, voffA);
            PG8_WAIT_V(8); PG8_WAIT_L(0); PG8_BAR; PG8_MMA(1, 0, At, B0); PG8_MMA(1, 1, At, B1); PG8_BAR; PG8_SCHED;
            PG8_LDB(B0, 1, 0); PG8_LDB(B1, 1, 1); PG8_SCHED; PG8_LDA(At, 1, 0); PG8_STAGE(PG8_SA(0, 1), a2 + hstepA, voffA);
            PG8_WAIT_V(8); PG8_WAIT_L(0); PG8_BAR; PG8_MMA(0, 0, At, B0); PG8_MMA(0, 1, At, B1); PG8_BAR; PG8_SCHED;
            PG8_LDA(At, 1, 1); PG8_STAGE(PG8_SB(1, 0), b3, voffB); PG8_STAGE(PG8_SB(1, 1), b3 + hstepB, voffB); PG8_STAGE(PG8_SA(1, 0), a3, voffA);
            PG8_WAIT_V(8); PG8_WAIT_L(0); PG8_BAR; PG8_MMA(1, 0, At, B0); PG8_MMA(1, 1, At, B1); PG8_BAR; PG8_SCHED;
            } else {
            PG8_LDB(B0, 0, 0); PG8_SCHED; PG8_LDA(At, 0, 0); PG8_STAGE(PG8_SA(1, 1), a1 + hstepA, voffA);
            PG8_WAIT_L(8); PG8_BAR; PG8_WAIT_L(0); PG8_MMA(0, 0, At, B0); PG8_BAR; PG8_SCHED;
            PG8_LDB(B1, 0, 1); PG8_STAGE(PG8_SB(0, 0), b2, voffB);
            PG8_BAR; PG8_WAIT_L(0); PG8_MMA(0, 1, At, B1); PG8_BAR;
            PG8_LDA(At, 0, 1); PG8_STAGE(PG8_SA(0, 0), a2, voffA);
            PG8_BAR; PG8_WAIT_L(0); PG8_MMA(1, 0, At, B0); PG8_BAR; PG8_SCHED;
            PG8_STAGE(PG8_SB(0, 1), b2 + hstepB, voffB);
            PG8_WAIT_V(6); PG8_BAR; PG8_MMA(1, 1, At, B1); PG8_BAR;
            PG8_LDB(B0, 1, 0); PG8_SCHED; PG8_LDA(At, 1, 0); PG8_STAGE(PG8_SA(0, 1), a2 + hstepA, voffA);
            PG8_WAIT_L(8); PG8_BAR; PG8_WAIT_L(0); PG8_MMA(0, 0, At, B0); PG8_BAR; PG8_SCHED;
            PG8_LDB(B1, 1, 1); PG8_STAGE(PG8_SB(1, 0), b3, voffB);
            PG8_BAR; PG8_WAIT_L(0); PG8_MMA(0, 1, At, B1); PG8_BAR;
            PG8_LDA(At, 1, 1); PG8_STAGE(PG8_SA(1, 0), a3, voffA);
            PG8_BAR; PG8_WAIT_L(0); PG8_MMA(1, 0, At, B0); PG8_BAR; PG8_SCHED;
            PG8_STAGE(PG8_SB(1, 1), b3 + hstepB, voffB);
            PG8_WAIT_V(6); PG8_BAR; PG8_MMA(1, 1, At, B1); PG8_BAR;
            }
        }
        if constexpr (ALIGN_EPI) { if (wr == 0) PG8_BAR; }
        E(acc, cur, wr, wc, fr, fq);
        if (!has_next) break;
#pragma unroll
        for (int a = 0; a < 2; ++a)
#pragma unroll
            for (int b = 0; b < 2; ++b)
#pragma unroll
                for (int m = 0; m < 4; ++m)
#pragma unroll
                    for (int n = 0; n < 2; ++n) acc[a][b][m][n] = (f32x4){0.f, 0.f, 0.f, 0.f};
        cur = nxt; cA = nA; cB = nB; ++ui;
        if constexpr (ALIGN_EPI) { if (wr == 1) PG8_BAR; }
    }
    PG8_WAIT_V(0);
    if constexpr (!ALIGN_EPI) { if (wr == 0) PG8_BAR; }
    PG8_BAR;
#undef PG8_SA
#undef PG8_SB
#undef PG8_STAGE
#undef PG8_LDA
#undef PG8_LDB
#undef PG8_MMA
#undef PG8_WAIT_V
#undef PG8_WAIT_L
#undef PG8_BAR
#undef PG8_SCHED
#undef PG8_ABASE
}
}

__device__ __forceinline__ float wave_max(float v) {
#pragma unroll
    for (int o = 1; o < 64; o <<= 1) v = fmaxf(v, __shfl_xor(v, o));
    return v;
}
__device__ __forceinline__ float wave_sum(float v) {
#pragma unroll
    for (int o = 1; o < 64; o <<= 1) v += __shfl_xor(v, o);
    return v;
}
struct Args;
constexpr int CI_IN = (DM / 64) * (INC / 64), CI_PW = 4 * (PGW / 64) * (PGW / 64), CI_WO = (DM / 64) * (DM / 64), CI_G = (DM / 64) * (DFF / 64), CI_D = (DFF / 64) * (DM / 64);
constexpr int CI_TOTAL = CI_IN + CI_PW + CI_WO + 2 * CI_G + CI_D;
constexpr int CVT_SPLIT = CI_IN + CI_PW + CI_WO + CI_G / 2;
struct CvtItem { const float* src; bf16_t* dst; const float* ks; int ldw, ldt; };
__device__ __forceinline__ void cvt_decode(int it, const Args& a, CvtItem& c);
__device__ __forceinline__ void cvt_load(const CvtItem& c, int lane, f32x4 (&va)[8], f32x4 (&vb)[8], float (&sa)[8], float (&sb)[8]) {
    const int kq = lane >> 4, nq = lane & 15;
    const float* p = c.src + (size_t)(2 * kq) * c.ldw + 4 * nq;
#pragma unroll
    for (int i = 0; i < 8; ++i) { va[i] = __builtin_nontemporal_load((const f32x4*)(p + (size_t)(8 * i) * c.ldw)); vb[i] = __builtin_nontemporal_load((const f32x4*)(p + (size_t)(8 * i + 1) * c.ldw)); }
    if (c.ks) {
#pragma unroll
        for (int i = 0; i < 8; ++i) { sa[i] = c.ks[8 * i + 2 * kq]; sb[i] = c.ks[8 * i + 2 * kq + 1]; }
    } else {
#pragma unroll
        for (int i = 0; i < 8; ++i) { sa[i] = 1.f; sb[i] = 1.f; }
    }
}
__device__ __forceinline__ void cvt_lds_write(LAS unsigned* tw, const f32x4 (&va)[8], const f32x4 (&vb)[8], const float (&sa)[8], const float (&sb)[8]) {
#pragma unroll
    for (int i = 0; i < 8; ++i)
#pragma unroll
        for (int j = 0; j < 4; ++j) tw[33 * j + 4 * i] = cvtpk(va[i][j] * sa[i], vb[i][j] * sb[i]);
}
__device__ __forceinline__ void cvt_store(const LAS unsigned* tr, const CvtItem& c, int lane) {
    bf16_t* dp = c.dst + (size_t)(lane >> 3) * c.ldt + 8 * (lane & 7);
#pragma unroll
    for (int jj = 0; jj < 8; ++jj) { u32x4 o; o.x = tr[8 * jj * 33 + 0]; o.y = tr[8 * jj * 33 + 1]; o.z = tr[8 * jj * 33 + 2]; o.w = tr[8 * jj * 33 + 3];
        *(u32x4*)(dp + (size_t)(8 * jj) * c.ldt) = o; }
}
__device__ __forceinline__ void cvt_range(const Args& a, int lo, int hi, int worker, int nworkers, LAS unsigned* T, int lane) {
    int it = lo + worker;
    f32x4 va[8], vb[8], wa[8], wb[8]; float sa[8], sb[8], ta[8], tb[8];
    CvtItem c0{}, c1{};
    if (it < hi) { cvt_decode(it, a, c0); cvt_load(c0, lane, va, vb, sa, sb); }
    if (it + nworkers < hi) { cvt_decode(it + nworkers, a, c1); cvt_load(c1, lane, wa, wb, ta, tb); }
    const int kq = lane >> 4, nq = lane & 15;
    LAS unsigned* tw = T + (4 * nq) * 33 + kq;
    const LAS unsigned* tr = T + (lane >> 3) * 33 + 4 * (lane & 7);
    while (it < hi) {
        {   CvtItem cc = c0;
            cvt_lds_write(tw, va, vb, sa, sb);
            if (it + 2 * nworkers < hi) { cvt_decode(it + 2 * nworkers, a, c0); cvt_load(c0, lane, va, vb, sa, sb); }
            cvt_store(tr, cc, lane); }
        it += nworkers; if (it >= hi) break;
        {   CvtItem cc = c1;
            cvt_lds_write(tw, wa, wb, ta, tb);
            if (it + 2 * nworkers < hi) { cvt_decode(it + 2 * nworkers, a, c1); cvt_load(c1, lane, wa, wb, ta, tb); }
            cvt_store(tr, cc, lane); }
        it += nworkers;
    }
}

struct Args { const float* in[13]; float* out; unsigned char* ws; };
__device__ __forceinline__ void cvt_decode(int it, const Args& a, CvtItem& c) {
    unsigned char* ws = a.ws; int q = it;
    if (q < CI_IN) { const int nblk = INC / 64, kb = q / nblk, nbk = q % nblk; c.src = a.in[2] + (size_t)(64 * kb) * INC + 64 * nbk; c.ldw = INC; c.dst = (bf16_t*)(ws + WS_WIN) + (size_t)(64 * nbk) * DM + 64 * kb; c.ldt = DM; c.ks = nullptr; return; } q -= CI_IN;
    if (q < CI_PW) { const int per = (PGW / 64) * (PGW / 64), grp = q / per, qq = q % per, nblk = PGW / 64, kb = qq / nblk, nbk = qq % nblk;
        c.src = a.in[6] + (size_t)grp * PGW * PGW + (size_t)(64 * kb) * PGW + 64 * nbk; c.ldw = PGW; c.dst = (bf16_t*)(ws + WS_PWT) + (size_t)(grp * PGW + 64 * nbk) * PGW + 64 * kb; c.ldt = PGW; c.ks = nullptr; return; } q -= CI_PW;
    if (q < CI_WO) { const int nblk = DM / 64, kb = q / nblk, nbk = q % nblk; c.src = a.in[8] + (size_t)(64 * kb) * DM + 64 * nbk; c.ldw = DM; c.dst = (bf16_t*)(ws + WS_WO) + (size_t)(64 * nbk) * DM + 64 * kb; c.ldt = DM; c.ks = nullptr; return; } q -= CI_WO;
    if (q < 2 * CI_G) { const int up = q >= CI_G ? 1 : 0, qq = q - up * CI_G, nblk = DFF / 64, kb = qq / nblk, nbk = qq % nblk, n0 = 64 * nbk;
        c.src = (up ? a.in[11] : a.in[10]) + (size_t)(64 * kb) * DFF + n0; c.ldw = DFF; c.dst = (bf16_t*)(ws + WS_WGU) + (size_t)((n0 >> 7) * 256 + up * 128 + (n0 & 127)) * DM + 64 * kb; c.ldt = DM; c.ks = a.in[9] + 64 * kb; return; } q -= 2 * CI_G;
    { const int nblk = DM / 64, kb = q / nblk, nbk = q % nblk; c.src = a.in[12] + (size_t)(64 * kb) * DM + 64 * nbk; c.ldw = DM; c.dst = (bf16_t*)(ws + WS_WD) + (size_t)(64 * nbk) * DFF + 64 * kb; c.ldt = DFF; c.ks = nullptr; }
}

constexpr int KROWB = 272, VROWB = 264;
__device__ __forceinline__ int crow(int reg, int h) { return (reg & 3) + 8 * (reg >> 2) + 4 * h; }

__device__ __forceinline__ unsigned attn_vload(u32x4 (&vw)[4], const bf16_t* __restrict__ QKVP, int nb, int kh, int vb, int tid) {
    const int kp = tid & 63, cgp = tid >> 6; const int kpos = (nb - 1) * 128 + vb * 128 + 2 * kp;
    const bool okv = (kpos >= 0) && (kpos < SEQ);
    const bf16_t* vp = QKVP + (size_t)(okv ? kpos : 0) * INC + VOFF + kh * HD + cgp * 16;
    vw[0] = *(const u32x4*)(vp); vw[1] = *(const u32x4*)(vp + INC); vw[2] = *(const u32x4*)(vp + 8); vw[3] = *(const u32x4*)(vp + INC + 8);
    return okv ? 0xffffffffu : 0u;
}
__device__ __forceinline__ void attn_vwrite(LAS unsigned char* Vt, const u32x4 (&vwr)[4], unsigned vmask, int tid) {
    const int kp = tid & 63, cgp = tid >> 6;
    LAS unsigned* vp = (LAS unsigned*)(Vt + (16 * cgp) * VROWB + kp * 4);
#pragma unroll
    for (int cc = 0; cc < 2; ++cc) { const u32x4 a = vwr[2 * cc] & vmask, b = vwr[2 * cc + 1] & vmask; LAS unsigned* q = vp + cc * 8 * (VROWB / 4);
        q[0 * (VROWB / 4)] = (a.x & 0xffffu) | (b.x << 16); q[1 * (VROWB / 4)] = (a.x >> 16) | (b.x & 0xffff0000u);
        q[2 * (VROWB / 4)] = (a.y & 0xffffu) | (b.y << 16); q[3 * (VROWB / 4)] = (a.y >> 16) | (b.y & 0xffff0000u);
        q[4 * (VROWB / 4)] = (a.z & 0xffffu) | (b.z << 16); q[5 * (VROWB / 4)] = (a.z >> 16) | (b.z & 0xffff0000u);
        q[6 * (VROWB / 4)] = (a.w & 0xffffu) | (b.w << 16); q[7 * (VROWB / 4)] = (a.w >> 16) | (b.w & 0xffff0000u); }
}
__device__ __forceinline__ void attn_qload(u32x4 (&qw)[8], const bf16_t* __restrict__ QKVP, int nb, int hq, int r0, int lane) {
    const bf16_t* qp = QKVP + (size_t)(nb * 128 + r0 + (lane & 31)) * INC + QOFF + hq * HD + 8 * (lane >> 5);
#pragma unroll
    for (int d0 = 0; d0 < 8; ++d0) qw[d0] = *(const u32x4*)(qp + 16 * d0);
}

__device__ __forceinline__ void attn_unit(LAS unsigned char* lds, const bf16_t* __restrict__ QKVP, bf16_t* __restrict__ MIX,
                                          const float* __restrict__ gq, const float* __restrict__ gk, const float* __restrict__ sinkl, int nb, int kh) {
    int tid = threadIdx.x; asm volatile("" : "+v"(tid));
    const int wid = __builtin_amdgcn_readfirstlane(tid >> 6);
    LAS unsigned char* Ks = lds; LAS unsigned char* Vt = lds + 384 * KROWB;
    const int hq = kh * 4 + (wid >> 1);
    u32x4 qw[8]; attn_qload(qw, QKVP, nb, hq, (wid & 1) * 64, tid & 63);
    {
        const int c = tid & 15, rr = tid >> 4;
        const f32x4 g0 = *(const f32x4*)(gk + c * 8), g1 = *(const f32x4*)(gk + c * 8 + 4);
        u32x4 kw[12];
#pragma unroll
        for (int pass = 0; pass < 12; ++pass) { const int kpos = (nb - 1) * 128 + pass * 32 + rr; const bool ok = (kpos >= 0 && kpos < SEQ);
            kw[pass] = *(const u32x4*)(QKVP + (size_t)(ok ? kpos : 0) * INC + KOFF + kh * HD + c * 8); }
#pragma unroll
        for (int pass = 0; pass < 12; ++pass) {
            const int j = pass * 32 + rr; const int kpos = (nb - 1) * 128 + j; const u32x4 w = kw[pass] & ((kpos >= 0 && kpos < SEQ) ? 0xffffffffu : 0u);
            const f32x4 a = (f32x4){bflo(w.x), bfhi(w.x), bflo(w.y), bfhi(w.y)}, b = (f32x4){bflo(w.z), bfhi(w.z), bflo(w.w), bfhi(w.w)};
            float ss = (a[0] * a[0] + a[1] * a[1]) + (a[2] * a[2] + a[3] * a[3]) + (b[0] * b[0] + b[1] * b[1]) + (b[2] * b[2] + b[3] * b[3]);
            ss += __shfl_xor(ss, 1); ss += __shfl_xor(ss, 2); ss += __shfl_xor(ss, 4); ss += __shfl_xor(ss, 8);
            const float rs = __builtin_amdgcn_rsqf(ss * (1.0f / HD) + EPS);
            const f32x4 oa = a * rs * g0, ob = b * rs * g1;
            u32x4 o; o.x = cvtpk(oa[0], oa[1]); o.y = cvtpk(oa[2], oa[3]); o.z = cvtpk(ob[0], ob[1]); o.w = cvtpk(ob[2], ob[3]);
            *(LAS u32x4*)(Ks + j * KROWB + c * 16) = o;
        }
    }
    u32x4 vw[4]; unsigned vmask = attn_vload(vw, QKVP, nb, kh, 0, tid);
    __syncthreads();
    const float slope2 = exp2f(-0.5f * (float)(hq + 1)) * LOG2E;
    const float sink2 = sinkl[hq] * LOG2E;
    float bnd;
    { const int l_ = tid & 63; const float a_ = fmaxf(fabsf(gq[l_]), fabsf(gq[l_ + 64])), b_ = fmaxf(fabsf(gk[l_]), fabsf(gk[l_ + 64]));
      bnd = wave_max(a_) * wave_max(b_) * (11.313708499f * LOG2E * 1.01f); }
    const bool use_bound = __builtin_amdgcn_readfirstlane(bnd < 45.0f ? 1 : 0) != 0;
#pragma unroll 1
    for (int qt = 0; qt < 2; ++qt) {
        int lane = tid & 63; asm volatile("" : "+v"(lane));
        const int r = lane & 31, h = lane >> 5;
        const int r0 = (wid & 1) * 64 + qt * 32;
        bf16x8 qf[8];
        {
            float ss = 0.f;
#pragma unroll
            for (int d0 = 0; d0 < 8; ++d0) {
                const float e0 = bflo(qw[d0].x), e1 = bfhi(qw[d0].x), e2 = bflo(qw[d0].y), e3 = bfhi(qw[d0].y), e4 = bflo(qw[d0].z), e5 = bfhi(qw[d0].z), e6 = bflo(qw[d0].w), e7 = bfhi(qw[d0].w);
                ss += (e0 * e0 + e1 * e1) + (e2 * e2 + e3 * e3) + (e4 * e4 + e5 * e5) + (e6 * e6 + e7 * e7); }
            ss += __shfl_xor(ss, 32);
            const float qs = __builtin_amdgcn_rsqf(ss * (1.0f / HD) + EPS) * (0.08838834764831845f * LOG2E);
#pragma unroll
            for (int d0 = 0; d0 < 8; ++d0) { const f32x4 ga = *(const f32x4*)(gq + 16 * d0 + 8 * h), gb = *(const f32x4*)(gq + 16 * d0 + 8 * h + 4);
                u32x4 o; o.x = cvtpk(bflo(qw[d0].x) * qs * ga[0], bfhi(qw[d0].x) * qs * ga[1]); o.y = cvtpk(bflo(qw[d0].y) * qs * ga[2], bfhi(qw[d0].y) * qs * ga[3]);
                o.z = cvtpk(bflo(qw[d0].z) * qs * gb[0], bfhi(qw[d0].z) * qs * gb[1]); o.w = cvtpk(bflo(qw[d0].w) * qs * gb[2], bfhi(qw[d0].w) * qs * gb[3]);
                qf[d0] = __builtin_bit_cast(bf16x8, o); }
        }
        const int hr = 4 * h - r;
        const int kt_first = (nb == 0) ? ((128 - r0 + 31) / 32 < 0 ? 0 : (128 - r0) / 32) : 0;
        const int kt_last = (nb == SEQ / 128 - 1) ? ((256 - r0) / 32 > 9 ? 9 : (256 - r0) / 32) : 9;
#define ATT_SCORES(kt_, sub_) \
        bf16x8 kf_[8]; { const LAS unsigned char* kp_ = Ks + (r0 + 32 * (kt_) + r) * KROWB + h * 16; \
            _Pragma("unroll") for (int d0 = 0; d0 < 8; ++d0) kf_[d0] = *(const LAS bf16x8*)(kp_ + d0 * 32); } \
        __builtin_amdgcn_sched_barrier(0);        \
        f32x16 s_; { const int dk_ = hr + 32 * (kt_) - 128; \
            _Pragma("unroll") for (int reg = 0; reg < 16; ++reg) s_[reg] = -slope2 * fabsf((float)(dk_ + crow(reg, 0))) - (sub_); \
            if ((kt_) == 0) { _Pragma("unroll") for (int reg = 0; reg < 16; ++reg) s_[reg] = (hr + crow(reg, 0) >= 0) ? s_[reg] : -1e30f; } \
            if ((kt_) == 8) { _Pragma("unroll") for (int reg = 0; reg < 16; ++reg) s_[reg] = (hr + crow(reg, 0) <= 0) ? s_[reg] : -1e30f; } \
            _Pragma("unroll") for (int d0 = 0; d0 < 8; ++d0) s_ = __builtin_amdgcn_mfma_f32_32x32x16_bf16(kf_[d0], qf[d0], s_, 0, 0, 0); }
        float mx = fmaxf(bnd, sink2);
        if (!use_bound) {
            mx = -1e30f;
#pragma unroll 1
            for (int kt = kt_first; kt < kt_last; ++kt) {
                ATT_SCORES(kt, 0.f)
#pragma unroll
                for (int reg = 0; reg < 16; ++reg) mx = fmaxf(mx, s_[reg]);
            }
            mx = fmaxf(mx, __shfl_xor(mx, 32)); mx = fmaxf(mx, sink2);
        }
        f32x16 o0 = {}, o1 = {}, o2 = {}, o3 = {}; float lsum = 0.f;
#pragma unroll 1
        for (int vb = 0; vb < 3; ++vb) {
            __syncthreads();
            attn_vwrite(Vt, vw, vmask, tid);
            { const int nvb = (vb == 2) ? 0 : vb + 1; if (!(qt == 1 && vb == 2)) vmask = attn_vload(vw, QKVP, nb, kh, nvb, tid); }
            __syncthreads();
            int kt_lo = (128 * vb - r0) / 32; if (kt_lo < kt_first) kt_lo = kt_first;
            int kt_hi = (128 * vb + 128 - r0) / 32; if (kt_hi > kt_last) kt_hi = kt_last;
#pragma unroll 1
            for (int kt = kt_lo; kt < kt_hi; ++kt) {
                ATT_SCORES(kt, mx)
                const int jl = r0 + 32 * kt - 128 * vb;
                u32x2 vfa[2][4], vfb[2][4];
#pragma unroll
                for (int st = 0; st < 2; ++st) { const LAS unsigned char* vbase = Vt + r * VROWB + (jl + 16 * st + 4 * h) * 2;
#pragma unroll
                    for (int dblk = 0; dblk < 4; ++dblk) { vfa[st][dblk] = *(const LAS u32x2*)(vbase + dblk * 32 * VROWB); vfb[st][dblk] = *(const LAS u32x2*)(vbase + dblk * 32 * VROWB + 16); } }
                __builtin_amdgcn_sched_barrier(0);
                float ps = 0.f;
#pragma unroll
                for (int reg = 0; reg < 16; ++reg) { s_[reg] = __builtin_amdgcn_exp2f(s_[reg]); ps += s_[reg]; }
                lsum += ps;
#pragma unroll
                for (int st = 0; st < 2; ++st) {
                    u32x4 pw; pw.x = cvtpk(s_[8 * st + 0], s_[8 * st + 1]); pw.y = cvtpk(s_[8 * st + 2], s_[8 * st + 3]); pw.z = cvtpk(s_[8 * st + 4], s_[8 * st + 5]); pw.w = cvtpk(s_[8 * st + 6], s_[8 * st + 7]);
                    const bf16x8 pa = __builtin_bit_cast(bf16x8, pw);
#define ATT_PV(ox, dblk) { const u32x4 vv_ = (u32x4){vfa[st][dblk].x, vfa[st][dblk].y, vfb[st][dblk].x, vfb[st][dblk].y}; ox = __builtin_amdgcn_mfma_f32_32x32x16_bf16(__builtin_bit_cast(bf16x8, vv_), pa, ox, 0, 0, 0); }
                    ATT_PV(o0, 0) ATT_PV(o1, 1) ATT_PV(o2, 2) ATT_PV(o3, 3)
#undef ATT_PV
                }
            }
        }
#undef ATT_SCORES
        if (qt == 0) attn_qload(qw, QKVP, nb, hq, r0 + 32, lane);
        lsum += __shfl_xor(lsum, 32);
        lsum += __builtin_amdgcn_exp2f(sink2 - mx);
        const float li = 1.0f / lsum;
        bf16_t* op = MIX + (size_t)(nb * 128 + r0 + r) * DM + hq * HD + 8 * h;
#define ATT_ST(ox, dblk) { _Pragma("unroll") for (int gp = 0; gp < 2; ++gp) { \
            const unsigned x0_ = cvtpk(ox[8 * gp + 0] * li, ox[8 * gp + 1] * li), x1_ = cvtpk(ox[8 * gp + 2] * li, ox[8 * gp + 3] * li); \
            const unsigned y0_ = cvtpk(ox[8 * gp + 4] * li, ox[8 * gp + 5] * li), y1_ = cvtpk(ox[8 * gp + 6] * li, ox[8 * gp + 7] * li); \
            const auto s0_ = __builtin_amdgcn_permlane32_swap(x0_, y0_, false, false); const auto s1_ = __builtin_amdgcn_permlane32_swap(x1_, y1_, false, false); \
            *(u32x4*)(op + (dblk) * 32 + gp * 16) = (u32x4){(unsigned)s0_[0], (unsigned)s1_[0], (unsigned)s0_[1], (unsigned)s1_[1]}; } }
        ATT_ST(o0, 0) ATT_ST(o1, 1) ATT_ST(o2, 2) ATT_ST(o3, 3)
#undef ATT_ST
    }
    __syncthreads();
}

__device__ __forceinline__ f32x4 bf4lo(const u32x4 w) { return (f32x4){bflo(w.x), bfhi(w.x), bflo(w.y), bfhi(w.y)}; }
__device__ __forceinline__ f32x4 bf4hi(const u32x4 w) { return (f32x4){bflo(w.z), bfhi(w.z), bflo(w.w), bfhi(w.w)}; }
__device__ __forceinline__ void pool_rows(const bf16_t* __restrict__ pb, bf16_t* __restrict__ ub, int grp, int blk0, int bstride) {
    const int L = 1 << grp, W = 2 << grp; const int nsteps = (16 + W - 1 + 3) & ~3;
    for (int blk = blk0; blk < SEQ / 16; blk += bstride) {
        const int t0 = blk * 16;
        f32x4 a0 = {0.f, 0.f, 0.f, 0.f}, a1 = {0.f, 0.f, 0.f, 0.f};
#pragma unroll 4
        for (int k = 0; k < nsteps; ++k) {
            const int ta = t0 - L + k, ts = ta - W, t = ta - L + 1;
            const bool oka = (ta >= 0) && (ta < SEQ), oks = (ts >= t0 - L) && (ts >= 0) && (ts < SEQ), oko = (t >= t0) && (t < t0 + 16);
            const u32x4 wa = *(const u32x4*)(pb + (size_t)(oka ? ta : t0) * INC), wsb = *(const u32x4*)(pb + (size_t)(oks ? ts : t0) * INC), wc = *(const u32x4*)(pb + (size_t)(oko ? t : t0) * INC);
            const float ma = oka ? 1.f : 0.f, ms = oks ? 1.f : 0.f;
            a0 += bf4lo(wa) * ma - bf4lo(wsb) * ms; a1 += bf4hi(wa) * ma - bf4hi(wsb) * ms;
            if (oko) {
                const int lo = (t - L) < 0 ? 0 : (t - L), hi = (t + L) > SEQ ? SEQ : (t + L);
                const float ic = 1.0f / (float)(hi - lo);
                const f32x4 u0 = a0 * ic - bf4lo(wc), u1 = a1 * ic - bf4hi(wc);
                u32x4 o; o.x = cvtpk(u0[0], u0[1]); o.y = cvtpk(u0[2], u0[3]); o.z = cvtpk(u1[0], u1[1]); o.w = cvtpk(u1[2], u1[3]);
                *(u32x4*)(ub + (size_t)t * PGW) = o;
            }
        }
    }
}

#define XB_TMO      128
#define XB_XCNT(j)  (256  + 64 * (j))
#define XB_XSUB(j)  (1280 + 64 * (j))
#define XB_XGEN(j)  (2304 + 64 * (j))
#define XB_TOP      3328
#define XB_TOPGEN   3392
#define XCD_BAR_WORDS 3456
#define XB_SPIN_CAP (1u << 18)
__device__ __forceinline__ unsigned xb_ld(unsigned* p)              { return __hip_atomic_load(p, __ATOMIC_RELAXED, __HIP_MEMORY_SCOPE_AGENT); }
__device__ __forceinline__ unsigned xb_add(unsigned* p, unsigned v) { return __hip_atomic_fetch_add(p, v, __ATOMIC_RELAXED, __HIP_MEMORY_SCOPE_AGENT); }
__device__ __forceinline__ unsigned xb_xcc_id() { return (unsigned)__builtin_amdgcn_s_getreg((3 << 11) | 20) & 0xFu; }
#define XB_SPIN(cond, bar) do { unsigned _sp = 0; while (cond) { __builtin_amdgcn_s_sleep(1); \
    if ((++_sp & 255u) == 0u) { if (xb_ld(&(bar)[XB_TMO])) break; if (_sp > XB_SPIN_CAP) { atomicAdd(&(bar)[XB_TMO], 1u); break; } } } } while (0)
struct XcdBarrier { unsigned* bar; unsigned x; volatile LAS unsigned* st; };
__device__ __forceinline__ XcdBarrier xcd_barrier_post(unsigned* bar, volatile LAS unsigned* st) {
    XcdBarrier b; b.bar = bar; b.x = xb_xcc_id(); b.st = st;
    if (threadIdx.x == 0) (void)xb_add(&bar[XB_XCNT(b.x)], 1u);
    return b;
}
__device__ __forceinline__ void xcd_barrier_complete(unsigned* bar, unsigned x, unsigned& nloc, unsigned& nx) {
    const unsigned G = gridDim.x * gridDim.y * gridDim.z;
    unsigned sum, cnt, mine, sp = 0u;
    for (;;) {
        sum = 0u; cnt = 0u; mine = 0u;
#pragma unroll
        for (unsigned j = 0; j < 16; ++j) { const unsigned c = xb_ld(&bar[XB_XCNT(j)]); sum += c; cnt += (c > 0u) ? 1u : 0u; mine = (j == x) ? c : mine; }
        if (sum == G) break;
        __builtin_amdgcn_s_sleep(1);
        if ((++sp & 255u) == 0u) { if (xb_ld(&bar[XB_TMO])) break; if (sp > XB_SPIN_CAP) { atomicAdd(&bar[XB_TMO], 1u); break; } }
    }
    nloc = mine > 0u ? mine : 1u; nx = cnt > 0u ? cnt : 1u;
}
__device__ __forceinline__ void xcd_barrier(const XcdBarrier& b) {
    asm volatile("s_waitcnt vmcnt(0)" ::: "memory");
    __syncthreads();
    if (threadIdx.x == 0) {
        unsigned* bar = b.bar;
        __builtin_amdgcn_s_waitcnt(0);
        unsigned nloc = b.st[0], nx = b.st[1];
        if (nloc == 0u) { xcd_barrier_complete(bar, b.x, nloc, nx); b.st[0] = nloc; b.st[1] = nx; }
        const unsigned old = xb_add(&bar[XB_XSUB(b.x)], 1u);
        const unsigned gen = old / nloc;
        if (old + 1u == (gen + 1u) * nloc) {
            __builtin_amdgcn_fence(__ATOMIC_RELEASE, "agent");
            asm volatile("s_waitcnt vmcnt(0)" ::: "memory");
            const unsigned og = xb_add(&bar[XB_TOP], 1u);
            const unsigned tg = og / nx;
            if (og + 1u == (tg + 1u) * nx) xb_add(&bar[XB_TOPGEN], 1u);
            else XB_SPIN(xb_ld(&bar[XB_TOPGEN]) == tg, bar);
            __builtin_amdgcn_fence(__ATOMIC_ACQUIRE, "agent");
            xb_add(&bar[XB_XGEN(b.x)], 1u);
            asm volatile("s_waitcnt vmcnt(0)" ::: "memory");
        } else {
            XB_SPIN(xb_ld(&bar[XB_XGEN(b.x)]) == gen, bar);
            __builtin_amdgcn_fence(__ATOMIC_ACQUIRE, "agent");
            asm volatile("s_waitcnt vmcnt(0)" ::: "memory");
        }
    }
    __syncthreads();
}

__global__ void __launch_bounds__(NWAVES * 64, 2) fwd_kernel(Args args) {
    extern __shared__ __attribute__((aligned(16))) unsigned char lds_raw[];
    LAS unsigned char* lds = (LAS unsigned char*)lds_raw;
    cg::grid_group grid = cg::this_grid();
    const int tid = threadIdx.x, lane = tid & 63, wave = __builtin_amdgcn_readfirstlane(tid >> 6);
    const int G = gridDim.x, bid = blockIdx.x;
    const int gw = bid * NWAVES + wave, NGW = G * NWAVES;
    const bool split_roles = (G == 256);
    unsigned char* ws = args.ws;
    volatile LAS unsigned* bst = (volatile LAS unsigned*)(lds + LDS_MISC);
    if (tid == 0) { bst[0] = 0u; bst[1] = 0u; }
    __syncthreads();
    const XcdBarrier xbar = xcd_barrier_post((unsigned*)(ws + WS_CTL), bst);
    const float* x = args.in[0]; const float* norm1_g = args.in[1]; const float* w_in = args.in[2]; const float* q_norm_g = args.in[3]; const float* k_norm_g = args.in[4];
    const float* sink_logits = args.in[5]; const float* pool_w = args.in[6]; const float* pool_scale = args.in[7]; const float* w_out = args.in[8]; const float* norm2_g = args.in[9];
    const float* w_gate = args.in[10]; const float* w_up = args.in[11]; const float* w_down = args.in[12];
    float* out = args.out;
    bf16_t* WinT = (bf16_t*)(ws + WS_WIN); bf16_t* PwT = (bf16_t*)(ws + WS_PWT); bf16_t* WoT = (bf16_t*)(ws + WS_WO); bf16_t* WguT = (bf16_t*)(ws + WS_WGU); bf16_t* WdT = (bf16_t*)(ws + WS_WD);
    bf16_t* XN = (bf16_t*)(ws + WS_XN); float* SSQ = (float*)(ws + WS_SSQ); bf16_t* QKVP = (bf16_t*)(ws + WS_QKVP); bf16_t* MIX = (bf16_t*)(ws + WS_MIX); bf16_t* U = (bf16_t*)(ws + WS_U); bf16_t* Hb = (bf16_t*)(ws + WS_H);

    {
        cvt_range(args, 0, split_roles ? CVT_SPLIT : CI_TOTAL, gw, NGW, (LAS unsigned*)(lds + wave * 16384), lane);
        for (int m = gw; m < SEQ; m += NGW) {
            const f32x4* xr = (const f32x4*)(x + (size_t)m * DM) + lane; const f32x4* gr = (const f32x4*)norm1_g + lane;
            f32x4 v[16]; float s = 0.f;
#pragma unroll
            for (int j = 0; j < 16; ++j) { v[j] = __builtin_nontemporal_load(xr + 64 * j); s += (v[j][0] * v[j][0] + v[j][1] * v[j][1]) + (v[j][2] * v[j][2] + v[j][3] * v[j][3]); }
            const float rstd = __builtin_amdgcn_rsqf(wave_sum(s) * (1.0f / DM) + EPS);
            u32x2* o8 = (u32x2*)(XN + (size_t)m * DM) + lane;
#pragma unroll
            for (int j = 0; j < 16; ++j) { const f32x4 gg = gr[64 * j]; const f32x4 y = v[j] * rstd * gg; u32x2 w; w.x = cvtpk(y[0], y[1]); w.y = cvtpk(y[2], y[3]); o8[64 * j] = w; }
        }
    }
    if (ws == nullptr) grid.sync();
    xcd_barrier(xbar);

    {
        if (!split_roles || bid < P1_GEMM_CUS) {
            pg8::Gemm g{XN, WinT, DM, DM, DM, 0, 0}; pg8::StaticOrder S; S.init(SEQ, INC, split_roles ? P1_GEMM_CUS : G, bid);
            pg8::EpiStore E{QKVP, INC};
            pg8::gemm_phase<pg8::EpiStore, true>(lds, g, S, E);
        } else {
            cvt_range(args, CVT_SPLIT, CI_TOTAL - CI_D, (bid - P1_GEMM_CUS) * NWAVES + wave, (G - P1_GEMM_CUS) * NWAVES, (LAS unsigned*)(lds + wave * 16384), lane);
        }
    }
    xcd_barrier(xbar);

    {
        for (int un = bid; un < (SEQ / 128) * NKV; un += G) {
            int nbq = un >> 2, khq = un & 3;
            if (G == 256) { const int x = un & 7, l = un >> 3; khq = x & 3; nbq = (x >> 2) * 32 + l; }
            attn_unit(lds, QKVP, MIX, q_norm_g, k_norm_g, sink_logits, nbq, khq);
        }
        {
            const int grp = gw & 3; const bf16_t* pb = QKVP + POFF + grp * PGW + lane * 8; bf16_t* ub = U + (size_t)grp * SEQ * PGW + lane * 8;
            pool_rows(pb, ub, grp, gw >> 2, NGW >> 2);
        }
    }
    xcd_barrier(xbar);

    {
        pg8::Gemm g{U, PwT, PGW, PGW, PGW, (long)SEQ * PGW, 1}; pg8::StaticOrder S; S.init(SEQ, PW, G, bid);
        pg8::EpiPool E{MIX, DM, PW, pool_scale};
        pg8::gemm_phase<pg8::EpiPool, true>(lds, g, S, E);
    }
    xcd_barrier(xbar);

    {
        pg8::Gemm g{MIX, WoT, DM, DM, DM, 0, 0}; pg8::StaticOrder S; S.init(SEQ, DM, G, bid);
        pg8::EpiWout E{x, XN, SSQ};
        pg8::gemm_phase<pg8::EpiWout, true>(lds, g, S, E);
    }
    xcd_barrier(xbar);

    {
        pg8::Gemm g{XN, WguT, DM, DM, DM, 0, 0}; pg8::StaticOrder S; S.init(SEQ, 2 * DFF, G, bid);
        LAS float* rstd_lds = (LAS float*)(lds + pg8::STAGE_BYTES);
        int pm_cached = -1;
        { pg8::Unit u0; if (S.next(0, u0)) { pm_cached = u0.pm;
            const int rowl = tid >> 1, hf = tid & 1; const f32x4* sp = (const f32x4*)(SSQ + (size_t)(pm_cached * 256 + rowl) * 64 + hf * 32);
            float sacc = 0.f;
#pragma unroll
            for (int q = 0; q < 8; ++q) { const f32x4 v = sp[q]; sacc += (v[0] + v[1]) + (v[2] + v[3]); }
            sacc += __shfl_xor(sacc, 1);
            if (hf == 0) rstd_lds[rowl] = __builtin_amdgcn_rsqf(sacc * (1.0f / DM) + EPS); } }
        __syncthreads();
        pg8::EpiGateUp E{Hb, SSQ, rstd_lds, pm_cached};
        pg8::gemm_phase<pg8::EpiGateUp, true>(lds, g, S, E);
        {
            const int nunits = (SEQ / 256) * (2 * DFF / 256), nfull = nunits % G;
            if (!split_roles) {}
            else if (nfull != 0 && bid >= nfull) cvt_range(args, CI_TOTAL - CI_D, CI_TOTAL, (bid - nfull) * NWAVES + wave, (G - nfull) * NWAVES, (LAS unsigned*)(lds + wave * 16384), lane);
            else if (nfull == 0) cvt_range(args, CI_TOTAL - CI_D, CI_TOTAL, gw, NGW, (LAS unsigned*)(lds + wave * 16384), lane);
        }
    }
    xcd_barrier(xbar);

    {
        pg8::Gemm g{Hb, WdT, DFF, DFF, DFF, 0, 0}; pg8::StaticOrder S; S.init(SEQ, DM, G, bid);
        pg8::EpiDown E{out, XN};
        pg8::gemm_phase<pg8::EpiDown, true>(lds, g, S, E);
    }
}

extern "C" void kernel_launch(void* const* d_in, const int* in_sizes, int n_in, void* d_out, int out_size, void* d_ws, size_t ws_size, hipStream_t stream) {
    static int grid = 0;
    if (grid == 0) {
        if (n_in != 13 || out_size != SEQ * DM || ws_size < WS_END) { fprintf(stderr, "kernel_launch: unexpected shapes (n_in %d out %d ws %zu)\n", n_in, out_size, ws_size); grid = -1; return; }
        int dev = 0, cus = 0, per_cu = 0;
        if (hipGetDevice(&dev) != hipSuccess || hipDeviceGetAttribute(&cus, hipDeviceAttributeMultiprocessorCount, dev) != hipSuccess) { grid = -1; return; }
        if (hipFuncSetAttribute((const void*)fwd_kernel, hipFuncAttributeMaxDynamicSharedMemorySize, LDS_BYTES) != hipSuccess) { fprintf(stderr, "kernel_launch: hipFuncSetAttribute failed\n"); grid = -1; return; }
        if (hipOccupancyMaxActiveBlocksPerMultiprocessor(&per_cu, (const void*)fwd_kernel, NWAVES * 64, LDS_BYTES) != hipSuccess || per_cu < 1) { fprintf(stderr, "kernel_launch: occupancy query gave %d\n", per_cu); per_cu = 1; }
        (void)hipGetLastError();
        grid = cus * 1;
    }
    if (grid < 0) return;
    Args a{};
    for (int i = 0; i < 13; ++i) a.in[i] = (const float*)d_in[i];
    a.out = (float*)d_out; a.ws = (unsigned char*)d_ws;
    if (hipMemsetAsync((char*)d_ws + WS_CTL, 0, CTL_BYTES, stream) != hipSuccess) { fprintf(stderr, "kernel_launch: memset of the barrier words failed\n"); return; }
    void* kargs[] = {&a};
    hipError_t e = hipLaunchCooperativeKernel((const void*)fwd_kernel, dim3(grid), dim3(NWAVES * 64), kargs, LDS_BYTES, stream);
    if (e != hipSuccess) fprintf(stderr, "kernel_launch: cooperative launch failed: %s (grid %d)\n", hipGetErrorString(e), grid);
}
```
